# Optimizing an MI355X kernel written in HIP

```python
import math
import jax, jax.numpy as jnp
from jax import lax
import numpy as np

D_MODEL = 2048
BATCH = 2
SEQ = 4096
DEPTH = 1

MIX_WIDTH = D_MODEL
GROUP_DIM = 128
CONV_WIDTH = MIX_WIDTH // 2
GM_WIDTH = MIX_WIDTH - CONV_WIDTH
CONV_GROUPS = CONV_WIDTH // GROUP_DIM
GM_HEADS = GM_WIDTH // GROUP_DIM
CONV_K = 3
CHUNK = 128
D_FF = 256 * math.ceil(8 * D_MODEL / 3 / 256)
N_MEM = 256
XA_HEADS = 4
XA_HEAD_DIM = D_MODEL // XA_HEADS
IN_COLS = 3 * CONV_WIDTH + 2 * GM_WIDTH
EPS = 1e-6

kernel_name = "hybrid_conv_gmlp_macaron_xattn"


def _rmsnorm(x, g):
    x32 = x.astype(jnp.float32)
    y = x32 * lax.rsqrt(jnp.mean(x32 * x32, axis=-1, keepdims=True) + EPS)
    return (y * g.astype(jnp.float32)).astype(x.dtype)


def _swiglu(x, w_in, w_out):
    gate, up = jnp.split(x @ w_in, 2, axis=-1)
    return (jax.nn.silu(gate) * up) @ w_out


def _causal_dwconv(z, conv_w, conv_b):
    s = z.shape[1]
    zp = jnp.pad(z, ((0, 0), (CONV_K - 1, 0), (0, 0)))
    y = conv_b + conv_w[CONV_K - 1] * z
    for k in range(CONV_K - 1):
        y = y + conv_w[k] * zp[:, k:k + s]
    return y


def _spatial_gating(u, v, g_v, w_s, b_s):
    b, s, _ = v.shape
    vh = v.reshape(b, s // CHUNK, CHUNK, GM_HEADS, GROUP_DIM)
    vh = _rmsnorm(vh, g_v.reshape(GM_HEADS, GROUP_DIM))
    mask = jnp.tril(jnp.ones((CHUNK, CHUNK), dtype=bool))
    w = jnp.where(mask[None], w_s, jnp.zeros_like(w_s)).astype(vh.dtype)
    sg = jnp.einsum('hts,bnshc->bnthc', w, vh) + b_s.T[None, None, :, :, None].astype(vh.dtype)
    return u * sg.reshape(b, s, GM_WIDTH)


def _cross_attention(n, mem_n, w_q, w_k, w_v, w_o):
    b, s, _ = n.shape
    m = mem_n.shape[1]
    q = (n @ w_q).reshape(b, s, XA_HEADS, XA_HEAD_DIM)
    k = (mem_n @ w_k).reshape(b, m, XA_HEADS, XA_HEAD_DIM)
    v = (mem_n @ w_v).reshape(b, m, XA_HEADS, XA_HEAD_DIM)
    scores = jnp.einsum('bshd,bmhd->bhsm', q, k).astype(jnp.float32) * (XA_HEAD_DIM ** -0.5)
    p = jax.nn.softmax(scores, axis=-1).astype(q.dtype)
    o = jnp.einsum('bhsm,bmhd->bshd', p, v).reshape(b, s, XA_HEADS * XA_HEAD_DIM)
    return o @ w_o


def setup_inputs(seed: int = 0) -> dict:
    key = jax.random.key(seed)
    ks = jax.random.split(key, 32)
    f32 = jnp.float32

    def w(k, shape, fan_in):
        return jax.random.normal(k, shape, f32) * (fan_in ** -0.5)

    def gain(k, shape):
        return 1.0 + 0.1 * jax.random.normal(k, shape, f32)

    L = DEPTH
    return {
        "x": jax.random.normal(ks[0], (BATCH, SEQ, D_MODEL), f32),
        "mem": jax.random.normal(ks[1], (BATCH, N_MEM, D_MODEL), f32),
        "g_ffn1": gain(ks[2], (L, D_MODEL)),
        "w_ffn1_in": w(ks[3], (L, D_MODEL, 2 * D_FF), D_MODEL),
        "w_ffn1_out": w(ks[4], (L, D_FF, D_MODEL), D_FF),
        "g_mix": gain(ks[5], (L, D_MODEL)),
        "w_mix_in": w(ks[6], (L, D_MODEL, IN_COLS), D_MODEL),
        "conv_w": w(ks[7], (L, CONV_K, CONV_WIDTH), CONV_K),
        "conv_b": 0.01 * jax.random.normal(ks[8], (L, CONV_WIDTH), f32),
        "g_gm_v": gain(ks[9], (L, GM_WIDTH)),
        "w_spatial": w(ks[10], (L, GM_HEADS, CHUNK, CHUNK), CHUNK),
        "b_spatial": 1.0 + 0.1 * jax.random.normal(ks[11], (L, GM_HEADS, CHUNK), f32),
        "w_mix_out": w(ks[12], (L, MIX_WIDTH, D_MODEL), MIX_WIDTH),
        "g_xattn": gain(ks[13], (L, D_MODEL)),
        "g_mem": gain(ks[14], (L, D_MODEL)),
        "w_xq": w(ks[15], (L, D_MODEL, D_MODEL), D_MODEL),
        "w_xk": w(ks[16], (L, D_MODEL, D_MODEL), D_MODEL),
        "w_xv": w(ks[17], (L, D_MODEL, D_MODEL), D_MODEL),
        "w_xo": w(ks[18], (L, D_MODEL, D_MODEL), D_MODEL),
        "g_ffn2": gain(ks[19], (L, D_MODEL)),
        "w_ffn2_in": w(ks[20], (L, D_MODEL, 2 * D_FF), D_MODEL),
        "w_ffn2_out": w(ks[21], (L, D_FF, D_MODEL), D_FF),
        "g_final": gain(ks[22], (D_MODEL,)),
    }


def reference(x, mem, g_ffn1, w_ffn1_in, w_ffn1_out, g_mix, w_mix_in, conv_w, conv_b,
              g_gm_v, w_spatial, b_spatial, w_mix_out, g_xattn, g_mem, w_xq, w_xk, w_xv,
              w_xo, g_ffn2, w_ffn2_in, w_ffn2_out, g_final):
    h = x
    splits = [CONV_WIDTH, 2 * CONV_WIDTH, 3 * CONV_WIDTH, 3 * CONV_WIDTH + GM_WIDTH]
    for l in range(DEPTH):
        h = h + 0.5 * _swiglu(_rmsnorm(h, g_ffn1[l]), w_ffn1_in[l], w_ffn1_out[l])

        z = _rmsnorm(h, g_mix[l]) @ w_mix_in[l]
        gate_b, gate_c, h_c, u, v = jnp.split(z, splits, axis=-1)
        y_conv = gate_b * _causal_dwconv(gate_c * h_c, conv_w[l], conv_b[l])
        y_gm = _spatial_gating(u, v, g_gm_v[l], w_spatial[l], b_spatial[l])
        h = h + jnp.concatenate([y_conv, y_gm], axis=-1) @ w_mix_out[l]

        h = h + _cross_attention(_rmsnorm(h, g_xattn[l]), _rmsnorm(mem, g_mem[l]),
                                 w_xq[l], w_xk[l], w_xv[l], w_xo[l])

        h = h + 0.5 * _swiglu(_rmsnorm(h, g_ffn2[l]), w_ffn2_in[l], w_ffn2_out[l])
    return _rmsnorm(h, g_final)
```

```cpp
#include <hip/hip_runtime.h>
#include <cstdio>
#include <cstdint>

#ifndef MK_PER_STEP
#define MK_PER_STEP 1
#endif

#define LAS __attribute__((address_space(3)))
typedef _Float16 f16_t;
typedef _Float16 f16x8 __attribute__((ext_vector_type(8)));
typedef _Float16 f16x2 __attribute__((ext_vector_type(2)));
typedef __fp16 fp16x4v __attribute__((__vector_size__(4 * sizeof(__fp16))));
typedef float f32x4 __attribute__((ext_vector_type(4)));
typedef unsigned u32x4 __attribute__((ext_vector_type(4)));
typedef unsigned u32x2 __attribute__((ext_vector_type(2)));

constexpr int NB = 2, SEQ = 4096, DM = 2048, TROWS = NB * SEQ;
constexpr int DFF = 5632, INC = 5120, CW = 1024, GMW = 1024, NMEM = 256, MROWS = NB * NMEM;
constexpr int XH = 4, XHD = 512;
constexpr float EPS = 1e-6f;
constexpr int NPART = 32;

__device__ __forceinline__ unsigned pk16(float a, float b) { f16x2 v = {(_Float16)a, (_Float16)b}; return __builtin_bit_cast(unsigned, v); }
__device__ __forceinline__ f16x2 as_h2(unsigned u) { const unsigned t = u; return __builtin_bit_cast(f16x2, t); }

namespace pg8 {
constexpr int BM = 256, BK = 64, HALF = 128, HTB = HALF * BK * 2  , STAGE_BYTES = 8 * HTB, NXCD = 8, WGM = 8;
__host__ __device__ __forceinline__ int lds_byte(int r, int c) { const int st = (r >> 4) * 2 + (c >> 5), rr = r & 15, cc = c & 31, ob = rr * 64 + cc * 2; return st * 1024 + (ob ^ (((ob >> 9) & 1) << 5)); }
__host__ __device__ __forceinline__ void stage_rc(int b, int& R, int& C) { const int st = b / 1024, sb = b % 1024, swz = sb ^ (((sb >> 9) & 1) << 5); R = (st >> 1) * 16 + swz / 64; C = (st & 1) * 32 + (swz % 64) / 2; }
__host__ __device__ __forceinline__ int perm32(int rho) { const int n = rho >> 4, i = rho & 15; return 8 * (i >> 2) + 4 * n + (i & 3); }

struct Unit { int pm, pn; };
struct Gemm { const f16_t* A; const f16_t* Bt; int M, N, K; };

struct StaticOrder {
    int nM, nN, nwg, G, c;
    __device__ void init(int M, int N, int G_, int c_) { nM = M / BM; nN = N / BM; nwg = nM * nN; G = G_; c = c_; }
    __device__ bool next(int i, Unit& u) const {
        const long L = (long)i * G + c; if (L >= nwg) return false;
        int wgid = (int)L; { const int q = nwg / NXCD, r = nwg % NXCD, xcd = wgid % NXCD, off = wgid / NXCD; wgid = (xcd < r ? xcd * (q + 1) : r * (q + 1) + (xcd - r) * q) + off; }
        const int nig = WGM * nN, gid = wgid / nig, fm = gid * WGM, gsz = (nM - fm) < WGM ? (nM - fm) : WGM;
        u.pm = fm + ((wgid % nig) % gsz); u.pn = (wgid % nig) / gsz; return true;
    }
};

__device__ __forceinline__ void row_rs(const float* part, int pm, int wr, int lane, float (&rsv)[2]) {
#pragma unroll
    for (int ai = 0; ai < 2; ++ai) {
        const f32x4* p = (const f32x4*)(part + (size_t)(pm * BM + ai * HALF + wr * 64 + lane) * NPART);
        f32x4 s = p[0];
#pragma unroll
        for (int j = 1; j < NPART / 4; ++j) s += p[j];
        rsv[ai] = __builtin_amdgcn_rsqf(((s[0] + s[1]) + (s[2] + s[3])) * (1.0f / DM) + EPS);
    }
}

struct EpiF16 {
    f16_t* O; int ldc; const float* part; float scale;
    __device__ __forceinline__ void operator()(const f32x4 (&acc)[2][2][4][2], const Unit& u, int wr, int wc, int fr, int fq) const {
        const int lane = fq * 16 + fr; float rsv[2] = {1.f, 1.f};
        if (part) row_rs(part, u.pm, wr, lane, rsv);
        const int row0 = u.pm * BM + wr * 64 + fr, col0 = u.pn * BM + wc * 32 + 8 * fq;
#pragma unroll
        for (int ai = 0; ai < 2; ++ai)
#pragma unroll
            for (int m = 0; m < 4; ++m) {
                float s = scale; if (part) s *= __shfl(rsv[ai], m * 16 + fr);
                f16_t* rowp = O + (size_t)(row0 + ai * HALF + m * 16) * ldc + col0;
#pragma unroll
                for (int bj = 0; bj < 2; ++bj) { const f32x4 v0 = acc[ai][bj][m][0] * s, v1 = acc[ai][bj][m][1] * s;
                    u32x4 w; w.x = pk16(v0[0], v0[1]); w.y = pk16(v0[2], v0[3]); w.z = pk16(v1[0], v1[1]); w.w = pk16(v1[2], v1[3]);
                    *(u32x4*)(rowp + bj * HALF) = w; } }
    }
};
struct EpiSwiGLU {
    f16_t* O; const float* part;
    __device__ __forceinline__ void operator()(const f32x4 (&acc)[2][2][4][2], const Unit& u, int wr, int wc, int fr, int fq) const {
        const int lane = fq * 16 + fr; float rsv[2] = {1.f, 1.f};
        if (part) row_rs(part, u.pm, wr, lane, rsv);
        const int row0 = u.pm * BM + wr * 64 + fr, col0 = u.pn * HALF + wc * 32 + 8 * fq;
#pragma unroll
        for (int ai = 0; ai < 2; ++ai)
#pragma unroll
            for (int m = 0; m < 4; ++m) {
                float s = 1.f; if (part) s = __shfl(rsv[ai], m * 16 + fr);
                float o[8];
#pragma unroll
                for (int n = 0; n < 2; ++n)
#pragma unroll
                    for (int j = 0; j < 4; ++j) { const float g = acc[ai][0][m][n][j] * s, up = acc[ai][1][m][n][j] * s;
                        const float e = __builtin_amdgcn_exp2f(g * -1.44269504089f); o[n * 4 + j] = g * __builtin_amdgcn_rcpf(1.0f + e) * up; }
                u32x4 w; w.x = pk16(o[0], o[1]); w.y = pk16(o[2], o[3]); w.z = pk16(o[4], o[5]); w.w = pk16(o[6], o[7]);
                *(u32x4*)(O + (size_t)(row0 + ai * HALF + m * 16) * DFF + col0) = w; }
    }
};
struct EpiRes {
    const float* base; float* H; f16_t* HG; const float* g; float* part; float alpha;
    __device__ __forceinline__ void operator()(const f32x4 (&acc)[2][2][4][2], const Unit& u, int wr, int wc, int fr, int fq) const {
        const int row0 = u.pm * BM + wr * 64 + fr, col0 = u.pn * BM + wc * 32 + 8 * fq;
        f32x4 gv[2][2];
#pragma unroll
        for (int bj = 0; bj < 2; ++bj)
#pragma unroll
            for (int n = 0; n < 2; ++n) gv[bj][n] = HG ? *(const f32x4*)(g + col0 + bj * HALF + 4 * n) : (f32x4){0.f, 0.f, 0.f, 0.f};
#pragma unroll
        for (int ai = 0; ai < 2; ++ai)
#pragma unroll
            for (int m = 0; m < 4; ++m) {
                const int row = row0 + ai * HALF + m * 16; const size_t off = (size_t)row * DM + col0; float ss = 0.f;
#pragma unroll
                for (int bj = 0; bj < 2; ++bj) {
                    const f32x4 b0 = *(const f32x4*)(base + off + bj * HALF), b1 = *(const f32x4*)(base + off + bj * HALF + 4);
                    const f32x4 h0 = b0 + acc[ai][bj][m][0] * alpha, h1 = b1 + acc[ai][bj][m][1] * alpha;
                    *(f32x4*)(H + off + bj * HALF) = h0; *(f32x4*)(H + off + bj * HALF + 4) = h1;
                    ss += (h0[0] * h0[0] + h0[1] * h0[1]) + (h0[2] * h0[2] + h0[3] * h0[3]) + (h1[0] * h1[0] + h1[1] * h1[1]) + (h1[2] * h1[2] + h1[3] * h1[3]);
                    if (HG) { const f32x4 a = h0 * gv[bj][0], b = h1 * gv[bj][1];
                        u32x4 w; w.x = pk16(a[0], a[1]); w.y = pk16(a[2], a[3]); w.z = pk16(b[0], b[1]); w.w = pk16(b[2], b[3]);
                        *(u32x4*)(HG + off + bj * HALF) = w; } }
                ss += __shfl_xor(ss, 16); ss += __shfl_xor(ss, 32);
                if (part && fq == 0) part[(size_t)row * NPART + u.pn * 4 + wc] = ss;
                if (m & 1) asm volatile("" ::: "memory"); }
    }
};

template <class Epi>
__device__ __forceinline__ void gemm_phase(LAS unsigned char* lds, const Gemm g, const StaticOrder& S, const Epi& E) {
    int tid_ = threadIdx.x; asm volatile("" : "+v"(tid_));
    const int tid = tid_, wid = __builtin_amdgcn_readfirstlane(tid >> 6), lane = tid & 63, wr = wid >> 2, wc = wid & 3, fr = lane & 15, fq = lane >> 4;
    const int K = g.K, nt = K / BK;
    unsigned voffA[2], voffB[2];
#pragma unroll
    for (int i = 0; i < 2; ++i) { int R, C; stage_rc(tid * 16 + i * 8192, R, C); const int Rb = (R & ~31) + perm32(R & 31);
        voffA[i] = (unsigned)(R * K + C) * 2u; voffB[i] = (unsigned)(Rb * K + C) * 2u; }
    const size_t kstep = (size_t)(BK * 2);
    const size_t hstep = (size_t)HALF * K * 2;
    const size_t tstep = 2 * hstep;
    const unsigned ldsw = (unsigned)wid * 1024u;
    const int aoff = lds_byte(wr * 64 + fr, fq * 8), boff = lds_byte(wc * 32 + fr, fq * 8);
#define PG8_SA(b, h) (((b) * 2 + (h)) * HTB)
#define PG8_SB(b, h) ((4 + (b) * 2 + (h)) * HTB)
#define PG8_STAGE(bufoff, gbase, voff) do { _Pragma("unroll") for (int _i = 0; _i < 2; ++_i) \
        __builtin_amdgcn_global_load_lds((const unsigned*)((const char*)(gbase) + (voff)[_i]), (LAS unsigned*)(lds + (bufoff) + ldsw + _i * 8192), 16, 0, 0); } while (0)
#define PG8_LDA(dst, b, h) do { _Pragma("unroll") for (int m = 0; m < 4; ++m) _Pragma("unroll") for (int k = 0; k < 2; ++k) dst[m][k] = *(const LAS f16x8*)(lds + PG8_SA(b, h) + aoff + m * 2048 + k * 1024); } while (0)
#define PG8_LDB(dst, b, h) do { _Pragma("unroll") for (int n = 0; n < 2; ++n) _Pragma("unroll") for (int k = 0; k < 2; ++k) dst[n][k] = *(const LAS f16x8*)(lds + PG8_SB(b, h) + boff + n * 2048 + k * 1024); } while (0)
#define PG8_MMA(ai, bj, At, Bt) do { __builtin_amdgcn_s_setprio(1); _Pragma("unroll") for (int m = 0; m < 4; ++m) _Pragma("unroll") for (int n = 0; n < 2; ++n) _Pragma("unroll") for (int k = 0; k < 2; ++k) \
        acc[ai][bj][m][n] = __builtin_amdgcn_mfma_f32_16x16x32_f16(Bt[n][k], At[m][k], acc[ai][bj][m][n], 0, 0, 0); __builtin_amdgcn_s_setprio(0); } while (0)
#define PG8_WAIT_V(n) asm volatile("s_waitcnt vmcnt(" #n ")" ::: "memory")
#define PG8_WAIT_L(n) asm volatile("s_waitcnt lgkmcnt(" #n ")" ::: "memory")
#define PG8_BAR __builtin_amdgcn_s_barrier()
#define PG8_SCHED __builtin_amdgcn_sched_barrier(0)
    Unit cur, nxt; int ui = 0;
    if (!S.next(0, cur)) return;
    f32x4 acc[2][2][4][2];
#pragma unroll
    for (int a = 0; a < 2; ++a)
#pragma unroll
        for (int b = 0; b < 2; ++b)
#pragma unroll
            for (int m = 0; m < 4; ++m)
#pragma unroll
                for (int n = 0; n < 2; ++n) acc[a][b][m][n] = (f32x4){0.f, 0.f, 0.f, 0.f};
    f16x8 At[4][2], B0[2][2], B1[2][2];
    const char* cA = (const char*)g.A + (size_t)cur.pm * tstep; const char* cB = (const char*)g.Bt + (size_t)cur.pn * tstep;
    PG8_STAGE(PG8_SB(0, 0), cB, voffB); PG8_STAGE(PG8_SB(0, 1), cB + hstep, voffB); PG8_STAGE(PG8_SA(0, 0), cA, voffA); PG8_STAGE(PG8_SA(0, 1), cA + hstep, voffA);
    if (wr == 1) PG8_BAR;
    PG8_WAIT_V(2); PG8_BAR;
    PG8_STAGE(PG8_SB(1, 0), cB + kstep, voffB); PG8_STAGE(PG8_SA(1, 0), cA + kstep, voffA); PG8_STAGE(PG8_SB(1, 1), cB + hstep + kstep, voffB);
    PG8_WAIT_V(6); PG8_BAR;
    for (;;) {
        const bool has_next = S.next(ui + 1, nxt);
        const char* nA = has_next ? (const char*)g.A + (size_t)nxt.pm * tstep : cA; const char* nB = has_next ? (const char*)g.Bt + (size_t)nxt.pn * tstep : cB;
        for (int t = 0; t < nt; t += 2) {
            const bool last = (t == nt - 2);
            const char* a1 = cA + (size_t)(t + 1) * kstep;
            const char* a2 = last ? nA : cA + (size_t)(t + 2) * kstep; const char* b2 = last ? nB : cB + (size_t)(t + 2) * kstep;
            const char* a3 = a2 + kstep; const char* b3 = b2 + kstep;
            PG8_LDB(B0, 0, 0); PG8_LDB(B1, 0, 1); PG8_SCHED; PG8_LDA(At, 0, 0); PG8_STAGE(PG8_SA(1, 1), a1 + hstep, voffA);
            PG8_WAIT_V(8); PG8_WAIT_L(0); PG8_BAR; PG8_MMA(0, 0, At, B0); PG8_MMA(0, 1, At, B1); PG8_BAR; PG8_SCHED;
            PG8_LDA(At, 0, 1); PG8_STAGE(PG8_SB(0, 0), b2, voffB); PG8_STAGE(PG8_SB(0, 1), b2 + hstep, voffB); PG8_STAGE(PG8_SA(0, 0), a2, voffA);
            PG8_WAIT_V(8); PG8_WAIT_L(0); PG8_BAR; PG8_MMA(1, 0, At, B0); PG8_MMA(1, 1, At, B1); PG8_BAR; PG8_SCHED;
            PG8_LDB(B0, 1, 0); PG8_LDB(B1, 1, 1); PG8_SCHED; PG8_LDA(At, 1, 0); PG8_STAGE(PG8_SA(0, 1), a2 + hstep, voffA);
            PG8_WAIT_V(8); PG8_WAIT_L(0); PG8_BAR; PG8_MMA(0, 0, At, B0); PG8_MMA(0, 1, At, B1); PG8_BAR; PG8_SCHED;
            PG8_LDA(At, 1, 1); PG8_STAGE(PG8_SB(1, 0), b3, voffB); PG8_STAGE(PG8_SB(1, 1), b3 + hstep, voffB); PG8_STAGE(PG8_SA(1, 0), a3, voffA);
            PG8_WAIT_V(8); PG8_WAIT_L(0); PG8_BAR; PG8_MMA(1, 0, At, B0); PG8_MMA(1, 1, At, B1); PG8_BAR; PG8_SCHED;
        }
        if (wr == 0) PG8_BAR;
        E(acc, cur, wr, wc, fr, fq);
        if (!has_next) break;
#pragma unroll
        for (int a = 0; a < 2; ++a)
#pragma unroll
            for (int b = 0; b < 2; ++b)
#pragma unroll
                for (int m = 0; m < 4; ++m)
#pragma unroll
                    for (int n = 0; n < 2; ++n) acc[a][b][m][n] = (f32x4){0.f, 0.f, 0.f, 0.f};
        cur = nxt; cA = nA; cB = nB; ++ui;
        if (wr == 1) PG8_BAR;
    }
    PG8_WAIT_V(0);
    PG8_BAR;
#undef PG8_SA
#undef PG8_SB
#undef PG8_STAGE
#undef PG8_LDA
#undef PG8_LDB
#undef PG8_MMA
#undef PG8_WAIT_V
#undef PG8_WAIT_L
#undef PG8_BAR
#undef PG8_SCHED
}
}

constexpr size_t MiB = 1u << 20;
constexpr size_t WS_CTL = 0, CTL_ZERO_BYTES = 64 * 1024;
constexpr size_t WS_PART1 = 1 * MiB, WS_PART2 = 2 * MiB, WS_PART3 = 3 * MiB;
constexpr size_t WS_WSP = 4 * MiB;
constexpr size_t WS_MEMN = 5 * MiB;
constexpr size_t WS_KV = 7 * MiB;
constexpr size_t WS_W1IN = 12 * MiB, WS_W1OUT = 56 * MiB, WS_WMIXIN = 78 * MiB, WS_WMIXOUT = 98 * MiB, WS_WQ = 106 * MiB, WS_WKV = 114 * MiB,
                 WS_WO = 130 * MiB, WS_W2IN = 138 * MiB, WS_W2OUT = 182 * MiB;
constexpr size_t WS_XA = 204 * MiB, WS_XB = 236 * MiB;
constexpr size_t WS_ACT = 268 * MiB;
constexpr size_t WS_END = 356 * MiB;
constexpr int CW_BAR = 4096;

constexpr int RING_BYTES = 131072;
constexpr int MISC_OFF = RING_BYTES;
constexpr int LDS_BYTES = 147456;

#define XB_TMO      128
#define XB_XCNT(j)  (256  + 64 * (j))
#define XB_XSUB(j)  (1280 + 64 * (j))
#define XB_XGEN(j)  (2304 + 64 * (j))
#define XB_TOP      3328
#define XB_TOPGEN   3392
#define XCD_BAR_WORDS 3456
#define XB_SPIN_CAP (1u << 20)
__device__ __forceinline__ unsigned xb_ld(unsigned* p)              { return __hip_atomic_load(p, __ATOMIC_RELAXED, __HIP_MEMORY_SCOPE_AGENT); }
__device__ __forceinline__ unsigned xb_add(unsigned* p, unsigned v) { return __hip_atomic_fetch_add(p, v, __ATOMIC_RELAXED, __HIP_MEMORY_SCOPE_AGENT); }
__device__ __forceinline__ unsigned xb_xcc_id() { return (unsigned)__builtin_amdgcn_s_getreg((3 << 11) | 20) & 0xFu; }
#define XB_SPIN(cond, bar) do { unsigned _sp = 0; while (cond) { __builtin_amdgcn_s_sleep(1); \
    if ((++_sp & 255u) == 0u) { if (xb_ld(&(bar)[XB_TMO])) break; if (_sp > XB_SPIN_CAP) { atomicAdd(&(bar)[XB_TMO], 1u); break; } } } } while (0)
struct XcdBarrier { unsigned* bar; unsigned x; volatile LAS unsigned* st; };
__device__ __forceinline__ XcdBarrier xcd_barrier_post(unsigned* bar, volatile LAS unsigned* st) {
    XcdBarrier b; b.bar = bar; b.x = xb_xcc_id(); b.st = st;
    if (threadIdx.x == 0) (void)xb_add(&bar[XB_XCNT(b.x)], 1u);
    return b;
}
__device__ __forceinline__ void xcd_barrier_complete(unsigned* bar, unsigned x, unsigned& nloc, unsigned& nx) {
    const unsigned G = gridDim.x * gridDim.y * gridDim.z;
    unsigned sum, cnt, mine, sp = 0u;
    for (;;) {
        sum = 0u; cnt = 0u; mine = 0u;
#pragma unroll
        for (unsigned j = 0; j < 16; ++j) { const unsigned c = xb_ld(&bar[XB_XCNT(j)]); sum += c; cnt += (c > 0u) ? 1u : 0u; mine = (j == x) ? c : mine; }
        if (sum == G) break;
        __builtin_amdgcn_s_sleep(1);
        if ((++sp & 255u) == 0u) { if (xb_ld(&bar[XB_TMO])) break; if (sp > XB_SPIN_CAP) { atomicAdd(&bar[XB_TMO], 1u); break; } }
    }
    nloc = mine > 0u ? mine : 1u; nx = cnt > 0u ? cnt : 1u;
}
__device__ __forceinline__ void xcd_barrier(const XcdBarrier& b) {
    asm volatile("s_waitcnt vmcnt(0)" ::: "memory");
    __syncthreads();
    if (threadIdx.x == 0) {
        unsigned* bar = b.bar;
        __builtin_amdgcn_s_waitcnt(0);
        unsigned nloc = b.st[0], nx = b.st[1];
        if (nloc == 0u) { xcd_barrier_complete(bar, b.x, nloc, nx); b.st[0] = nloc; b.st[1] = nx; }
        const unsigned old = xb_add(&bar[XB_XSUB(b.x)], 1u);
        const unsigned gen = old / nloc;
        if (old + 1u == (gen + 1u) * nloc) {
            __builtin_amdgcn_fence(__ATOMIC_RELEASE, "agent");
            asm volatile("s_waitcnt vmcnt(0)" ::: "memory");
            const unsigned og = xb_add(&bar[XB_TOP], 1u);
            const unsigned tg = og / nx;
            if (og + 1u == (tg + 1u) * nx) xb_add(&bar[XB_TOPGEN], 1u);
            else XB_SPIN(xb_ld(&bar[XB_TOPGEN]) == tg, bar);
            __builtin_amdgcn_fence(__ATOMIC_ACQUIRE, "agent");
            xb_add(&bar[XB_XGEN(b.x)], 1u);
            asm volatile("s_waitcnt vmcnt(0)" ::: "memory");
        } else {
            XB_SPIN(xb_ld(&bar[XB_XGEN(b.x)]) == gen, bar);
            __builtin_amdgcn_fence(__ATOMIC_ACQUIRE, "agent");
            asm volatile("s_waitcnt vmcnt(0)" ::: "memory");
        }
    }
    __syncthreads();
}

#define LDS_WAIT() asm volatile("s_waitcnt lgkmcnt(0)" ::: "memory")
__device__ __forceinline__ float wave_sum(float v) {
#pragma unroll
    for (int o = 1; o < 64; o <<= 1) v += __shfl_xor(v, o);
    return v;
}
__device__ __forceinline__ void transpose_item(const float* W, int N, f16_t* WT, int K, int dst_row0, int k0, int n0, LAS float* scr, int lane) {
#pragma unroll 8
    for (int i = 0; i < 32; ++i) { const int kk = 2 * i + (lane >> 5); scr[kk * 33 + (lane & 31)] = W[(size_t)(k0 + kk) * N + n0 + (lane & 31)]; }
    LDS_WAIT(); asm volatile("" ::: "memory");
    const int c = lane & 7;
#pragma unroll
    for (int j = 0; j < 4; ++j) { const int n = (lane >> 3) + 8 * j; const LAS float* s = scr + (8 * c) * 33 + n;
        u32x4 o; o.x = pk16(s[0 * 33], s[1 * 33]); o.y = pk16(s[2 * 33], s[3 * 33]); o.z = pk16(s[4 * 33], s[5 * 33]); o.w = pk16(s[6 * 33], s[7 * 33]);
        *(u32x4*)(WT + (size_t)(dst_row0 + n) * K + k0 + 8 * c) = o; }
    LDS_WAIT(); asm volatile("" ::: "memory");
}
__device__ __forceinline__ void prep_mat(const float* W, int K, int N, f16_t* WT, int row_off, bool ileave, int r, LAS float* scr, int lane) {
    const int nblk = N / 32, kb = r / nblk, nb = r - kb * nblk, n0 = 32 * nb;
    int dr;
    if (ileave) { const int half = N / 2, up = n0 >= half ? 1 : 0, nn = n0 - up * half; dr = (nn >> 7) * 256 + up * 128 + (nn & 127); } else dr = row_off + n0;
    transpose_item(W, N, WT, K, dr, 64 * kb, n0, scr, lane);
}
__device__ __forceinline__ void norm_row_f16(const float* xrow, const float* g, f16_t* orow, int lane) {
    const f32x4* xr = (const f32x4*)xrow + lane; const f32x4* gr = (const f32x4*)g + lane;
    f32x4 v[8]; float s = 0.f;
#pragma unroll
    for (int j = 0; j < 8; ++j) { v[j] = xr[64 * j]; s += (v[j][0] * v[j][0] + v[j][1] * v[j][1]) + (v[j][2] * v[j][2] + v[j][3] * v[j][3]); }
    const float rs = __builtin_amdgcn_rsqf(wave_sum(s) * (1.f / DM) + EPS);
    u32x2* o8 = (u32x2*)orow + lane;
#pragma unroll
    for (int j = 0; j < 8; ++j) { const f32x4 gg = gr[64 * j]; u32x2 w; w.x = pk16(v[j][0] * rs * gg[0], v[j][1] * rs * gg[1]); w.y = pk16(v[j][2] * rs * gg[2], v[j][3] * rs * gg[3]); o8[64 * j] = w; }
}

struct Args { const float* in[23]; float* out; unsigned char* ws; int lo, hi; };
__device__ __forceinline__ const float* inp(int i) {
    const __attribute__((address_space(4))) unsigned long long* t = (const __attribute__((address_space(4))) unsigned long long*)__builtin_amdgcn_kernarg_segment_ptr();
    asm volatile("" : "+s"(i));
    return (const float*)t[i];
}
enum { I_X = 0, I_MEM, I_GFFN1, I_W1IN, I_W1OUT, I_GMIX, I_WMIXIN, I_CONVW, I_CONVB, I_GGMV, I_WSP, I_BSP, I_WMIXOUT, I_GXATTN, I_GMEM, I_WQ, I_WK, I_WV, I_WO, I_GFFN2, I_W2IN, I_W2OUT, I_GFINAL };
enum { ST_PREP = 0, ST_G1, ST_G2, ST_G3, ST_KV, ST_MIX, ST_G4, ST_G5, ST_ATT, ST_G6, ST_G7, ST_G8, ST_FIN, ST_N };

__device__ __forceinline__ void step_prep(const Args& a, LAS unsigned char* lds, int G, int vcu, int tid, int wave, int lane) {
    unsigned char* ws = a.ws;
    LAS float* scr = (LAS float*)(lds + wave * 16384);
    const int gw = vcu * 8 + wave, NGW = G * 8;
    constexpr int I_FIN = (DM / 64) * (2 * DFF / 32), I_FOUT = (DFF / 64) * (DM / 32), I_MIXIN = (DM / 64) * (INC / 32), I_SQ = (DM / 64) * (DM / 32);
    constexpr int NITEMS = 2 * I_FIN + 2 * I_FOUT + I_MIXIN + 5 * I_SQ;
    for (int it = gw; it < NITEMS; it += NGW) {
        int r = it;
        if (r < I_FIN) { prep_mat(inp(I_W1IN), DM, 2 * DFF, (f16_t*)(ws + WS_W1IN), 0, true, r, scr, lane); continue; } r -= I_FIN;
        if (r < I_FOUT) { prep_mat(inp(I_W1OUT), DFF, DM, (f16_t*)(ws + WS_W1OUT), 0, false, r, scr, lane); continue; } r -= I_FOUT;
        if (r < I_MIXIN) { prep_mat(inp(I_WMIXIN), DM, INC, (f16_t*)(ws + WS_WMIXIN), 0, false, r, scr, lane); continue; } r -= I_MIXIN;
        if (r < I_SQ) { prep_mat(inp(I_WMIXOUT), DM, DM, (f16_t*)(ws + WS_WMIXOUT), 0, false, r, scr, lane); continue; } r -= I_SQ;
        if (r < I_SQ) { prep_mat(inp(I_WQ), DM, DM, (f16_t*)(ws + WS_WQ), 0, false, r, scr, lane); continue; } r -= I_SQ;
        if (r < I_SQ) { prep_mat(inp(I_WK), DM, DM, (f16_t*)(ws + WS_WKV), 0, false, r, scr, lane); continue; } r -= I_SQ;
        if (r < I_SQ) { prep_mat(inp(I_WV), DM, DM, (f16_t*)(ws + WS_WKV), DM, false, r, scr, lane); continue; } r -= I_SQ;
        if (r < I_SQ) { prep_mat(inp(I_WO), DM, DM, (f16_t*)(ws + WS_WO), 0, false, r, scr, lane); continue; } r -= I_SQ;
        if (r < I_FIN) { prep_mat(inp(I_W2IN), DM, 2 * DFF, (f16_t*)(ws + WS_W2IN), 0, true, r, scr, lane); continue; } r -= I_FIN;
        prep_mat(inp(I_W2OUT), DFF, DM, (f16_t*)(ws + WS_W2OUT), 0, false, r, scr, lane);
    }
    for (int m = gw; m < TROWS; m += NGW) norm_row_f16(inp(I_X) + (size_t)m * DM, inp(I_GFFN1), (f16_t*)(ws + WS_XA) + (size_t)m * DM, lane);
    for (int m = gw; m < MROWS; m += NGW) norm_row_f16(inp(I_MEM) + (size_t)m * DM, inp(I_GMEM), (f16_t*)(ws + WS_MEMN) + (size_t)m * DM, lane);
    { const f32x4* src = (const f32x4*)inp(I_WSP); u32x2* dst = (u32x2*)(ws + WS_WSP);
      for (int i = vcu * 512 + tid; i < 8 * 128 * 128 / 4; i += G * 512) { const int t = (i >> 5) & 127, s0 = (i & 31) * 4; const f32x4 v = src[i];
          u32x2 w; w.x = pk16(s0 <= t ? v[0] : 0.f, s0 + 1 <= t ? v[1] : 0.f); w.y = pk16(s0 + 2 <= t ? v[2] : 0.f, s0 + 3 <= t ? v[3] : 0.f); dst[i] = w; } }
}

__device__ __forceinline__ void f16x8_to_f32(const u32x4 w, float (&f)[8]) {
#pragma unroll
    for (int j = 0; j < 4; ++j) { const f16x2 h = as_h2(w[j]); f[2 * j] = (float)h[0]; f[2 * j + 1] = (float)h[1]; }
}
__device__ __forceinline__ void conv_unit(const Args& a, int cu, int tid) {
    const f16_t* Z = (const f16_t*)(a.ws + WS_ACT); f16_t* Y = (f16_t*)(a.ws + WS_XA);
    const int cg = tid & 127, rg = tid >> 7, c = 8 * cg, r0 = 32 * cu + 8 * rg;
    float w0[8], w1[8], w2[8], cb[8];
    { const f32x4* p = (const f32x4*)(inp(I_CONVW) + c); const f32x4 a0 = p[0], a1 = p[1], b0 = p[CW / 4], b1 = p[CW / 4 + 1], c0 = p[2 * CW / 4], c1 = p[2 * CW / 4 + 1];
      const f32x4* q = (const f32x4*)(inp(I_CONVB) + c); const f32x4 d0 = q[0], d1 = q[1];
#pragma unroll
      for (int j = 0; j < 4; ++j) { w0[j] = a0[j]; w0[4 + j] = a1[j]; w1[j] = b0[j]; w1[4 + j] = b1[j]; w2[j] = c0[j]; w2[4 + j] = c1[j]; cb[j] = d0[j]; cb[4 + j] = d1[j]; } }
    float m2[8], m1[8];
    const bool first = (r0 & (SEQ - 1)) == 0;
    {
        float x[8], y[8];
        if (!first) {
            f16x8_to_f32(*(const u32x4*)(Z + (size_t)(r0 - 2) * INC + CW + c), x); f16x8_to_f32(*(const u32x4*)(Z + (size_t)(r0 - 2) * INC + 2 * CW + c), y);
#pragma unroll
            for (int j = 0; j < 8; ++j) m2[j] = x[j] * y[j];
            f16x8_to_f32(*(const u32x4*)(Z + (size_t)(r0 - 1) * INC + CW + c), x); f16x8_to_f32(*(const u32x4*)(Z + (size_t)(r0 - 1) * INC + 2 * CW + c), y);
#pragma unroll
            for (int j = 0; j < 8; ++j) m1[j] = x[j] * y[j];
        } else {
#pragma unroll
            for (int j = 0; j < 8; ++j) { m2[j] = 0.f; m1[j] = 0.f; }
        }
    }
#pragma unroll
    for (int rr = 0; rr < 8; ++rr) {
        const size_t ro = (size_t)(r0 + rr) * INC + c;
        float gb[8], gc[8], hc[8], o[8];
        f16x8_to_f32(*(const u32x4*)(Z + ro), gb); f16x8_to_f32(*(const u32x4*)(Z + ro + CW), gc); f16x8_to_f32(*(const u32x4*)(Z + ro + 2 * CW), hc);
#pragma unroll
        for (int j = 0; j < 8; ++j) { const float ch = gc[j] * hc[j]; o[j] = gb[j] * (cb[j] + w2[j] * ch + w1[j] * m1[j] + w0[j] * m2[j]); m2[j] = m1[j]; m1[j] = ch; }
        u32x4 w; w.x = pk16(o[0], o[1]); w.y = pk16(o[2], o[3]); w.z = pk16(o[4], o[5]); w.w = pk16(o[6], o[7]);
        *(u32x4*)(Y + (size_t)(r0 + rr) * DM + c) = w;
    }
}
constexpr int VNT_PITCH = 272;
__device__ __forceinline__ void gm_unit(const Args& a, LAS unsigned char* lds, int gu, int tid, int wave, int lane) {
    const f16_t* Z = (const f16_t*)(a.ws + WS_ACT); f16_t* Y = (f16_t*)(a.ws + WS_XA); const f16_t* WSP = (const f16_t*)(a.ws + WS_WSP);
    const int head = gu & 7, R0 = (gu >> 3) * 128;
    { const int ch = tid & 15, sr = tid >> 4; float gg[8];
      { const f32x4* p = (const f32x4*)(inp(I_GGMV) + head * 128 + 8 * ch); const f32x4 g0 = p[0], g1 = p[1];
#pragma unroll
        for (int j = 0; j < 4; ++j) { gg[j] = g0[j]; gg[4 + j] = g1[j]; } }
#pragma unroll
      for (int ps = 0; ps < 4; ++ps) { const int s = sr + 32 * ps; float v[8];
          f16x8_to_f32(*(const u32x4*)(Z + (size_t)(R0 + s) * INC + 4 * CW + head * 128 + 8 * ch), v);
          float ss = 0.f;
#pragma unroll
          for (int j = 0; j < 8; ++j) ss += v[j] * v[j];
          ss += __shfl_xor(ss, 1); ss += __shfl_xor(ss, 2); ss += __shfl_xor(ss, 4); ss += __shfl_xor(ss, 8);
          const float rs = __builtin_amdgcn_rsqf(ss * (1.f / 128.f) + EPS);
#pragma unroll
          for (int j = 0; j < 8; ++j) *(LAS f16_t*)(lds + (8 * ch + j) * VNT_PITCH + 2 * s) = (f16_t)(v[j] * rs * gg[j]); } }
    __syncthreads();
    const int fr = lane & 15, g = lane >> 4;
    f16x8 Af[4];
#pragma unroll
    for (int ks = 0; ks < 4; ++ks) Af[ks] = *(const LAS f16x8*)(lds + (16 * wave + fr) * VNT_PITCH + (32 * ks + 8 * g) * 2);
    f32x4 acc[8];
    const f16_t* wrow = WSP + (size_t)head * 128 * 128 + (size_t)fr * 128 + 8 * g;
#pragma unroll
    for (int tb = 0; tb < 8; ++tb) { acc[tb] = (f32x4){0.f, 0.f, 0.f, 0.f};
#pragma unroll
        for (int ks = 0; ks < 4; ++ks) if (32 * ks <= 16 * tb + 15) { const f16x8 Bf = *(const f16x8*)(wrow + (size_t)tb * 16 * 128 + 32 * ks);
            acc[tb] = __builtin_amdgcn_mfma_f32_16x16x32_f16(Af[ks], Bf, acc[tb], 0, 0, 0); } }
#pragma unroll
    for (int tb = 0; tb < 8; ++tb) { const int t = 16 * tb + fr; const float bs = inp(I_BSP)[head * 128 + t];
        const size_t ro = (size_t)(R0 + t); const int cc = head * 128 + 16 * wave + 4 * g;
        const u32x2 uw = *(const u32x2*)(Z + ro * INC + 3 * CW + cc); const f16x2 u0 = as_h2(uw.x), u1 = as_h2(uw.y);
        u32x2 w; w.x = pk16((float)u0[0] * (acc[tb][0] + bs), (float)u0[1] * (acc[tb][1] + bs)); w.y = pk16((float)u1[0] * (acc[tb][2] + bs), (float)u1[1] * (acc[tb][3] + bs));
        *(u32x2*)(Y + ro * DM + CW + cc) = w; }
    __syncthreads();
}

__device__ __forceinline__ void attn_unit(const Args& a, LAS unsigned char* lds, int b, int h, int qb, int tid, int wave, int lane) {
    const f16_t* Q = (const f16_t*)(a.ws + WS_XA); const f16_t* KV = (const f16_t*)(a.ws + WS_KV); f16_t* O = (f16_t*)(a.ws + WS_XB);
    const int fr = lane & 15, g = lane >> 4;
    const int R0 = b * SEQ + qb * 128 + wave * 16;
    f16x8 Qf[16];
    { const f16_t* qp = Q + (size_t)(R0 + fr) * DM + h * XHD + 8 * g;
#pragma unroll
      for (int kk = 0; kk < 16; ++kk) Qf[kk] = *(const f16x8*)(qp + 32 * kk); }
    const int srow = tid >> 3, sc = tid & 7;
    const f16_t* kbase = KV + (size_t)(b * NMEM + srow) * (2 * DM) + h * XHD + sc * 8;
    const unsigned swoff = (unsigned)(srow * 128 + ((sc ^ (srow & 7)) << 4));
    u32x4 st[4];
#define AT_LOAD(c) do { const f16_t* _p = kbase + ((c) >= 8 ? DM : 0) + 64 * ((c) & 7); _Pragma("unroll") for (int _i = 0; _i < 4; ++_i) st[_i] = *(const u32x4*)(_p + (size_t)_i * 64 * (2 * DM)); } while (0)
#define AT_WRITE(buf) do { _Pragma("unroll") for (int _i = 0; _i < 4; ++_i) *(LAS u32x4*)(lds + (buf) * 32768 + swoff + _i * 8192) = st[_i]; } while (0)
    AT_LOAD(0); AT_WRITE(0); __syncthreads();
    f32x4 S[16];
#pragma unroll
    for (int i = 0; i < 16; ++i) S[i] = (f32x4){0.f, 0.f, 0.f, 0.f};
    unsigned aoffK[2];
#pragma unroll
    for (int ks = 0; ks < 2; ++ks) aoffK[ks] = (unsigned)(fr * 128 + (((4 * ks + g) ^ (fr & 7)) << 4));
#pragma unroll
    for (int dc = 0; dc < 8; ++dc) {
        AT_LOAD(dc + 1);
        const LAS unsigned char* bp = lds + (dc & 1) * 32768;
#pragma unroll
        for (int mt = 0; mt < 16; ++mt)
#pragma unroll
            for (int ks = 0; ks < 2; ++ks) S[mt] = __builtin_amdgcn_mfma_f32_16x16x32_f16(*(const LAS f16x8*)(bp + mt * 2048 + aoffK[ks]), Qf[2 * dc + ks], S[mt], 0, 0, 0);
        AT_WRITE((dc + 1) & 1); __syncthreads();
    }
    float mx = S[0][0];
#pragma unroll
    for (int i = 0; i < 16; ++i) mx = fmaxf(fmaxf(mx, fmaxf(S[i][0], S[i][1])), fmaxf(S[i][2], S[i][3]));
    mx = fmaxf(mx, __shfl_xor(mx, 16)); mx = fmaxf(mx, __shfl_xor(mx, 32));
    float l = 0.f;
#pragma unroll
    for (int i = 0; i < 16; ++i)
#pragma unroll
        for (int r = 0; r < 4; ++r) { const float p = __builtin_amdgcn_exp2f(S[i][r] - mx); S[i][r] = p; l += p; }
    l += __shfl_xor(l, 16); l += __shfl_xor(l, 32);
    const float inv_l = 1.0f / l;
    f16x8 Pf[8];
#pragma unroll
    for (int ks = 0; ks < 8; ++ks) { u32x4 w; w.x = pk16(S[2 * ks][0], S[2 * ks][1]); w.y = pk16(S[2 * ks][2], S[2 * ks][3]); w.z = pk16(S[2 * ks + 1][0], S[2 * ks + 1][1]); w.w = pk16(S[2 * ks + 1][2], S[2 * ks + 1][3]);
        Pf[ks] = __builtin_bit_cast(f16x8, w); }
    const int q4 = fr >> 2, p4 = fr & 3;
    unsigned voff[4];
#pragma unroll
    for (int dt = 0; dt < 4; ++dt) voff[dt] = (unsigned)((4 * g + q4) * 128 + (((2 * dt + (p4 >> 1)) ^ (((g & 1) << 2) + q4)) << 4) + (p4 & 1) * 8);
    f16_t* orow = O + (size_t)(R0 + fr) * DM + h * XHD + 4 * g;
    for (int dc = 0; dc < 8; ++dc) {
        if (dc < 7) AT_LOAD(dc + 9);
        const LAS unsigned char* bp = lds + (dc & 1) * 32768;
#pragma unroll
        for (int dt = 0; dt < 4; ++dt) { f32x4 o = (f32x4){0.f, 0.f, 0.f, 0.f};
#pragma unroll
            for (int ks = 0; ks < 8; ++ks) {
                const fp16x4v t1 = __builtin_amdgcn_ds_read_tr16_b64_v4f16((LAS fp16x4v*)(bp + ks * 4096 + voff[dt]));
                const fp16x4v t2 = __builtin_amdgcn_ds_read_tr16_b64_v4f16((LAS fp16x4v*)(bp + ks * 4096 + 2048 + voff[dt]));
                const u32x2 w1 = __builtin_bit_cast(u32x2, t1), w2 = __builtin_bit_cast(u32x2, t2); const u32x4 w = {w1.x, w1.y, w2.x, w2.y};
                o = __builtin_amdgcn_mfma_f32_16x16x32_f16(__builtin_bit_cast(f16x8, w), Pf[ks], o, 0, 0, 0); }
            u32x2 w; w.x = pk16(o[0] * inv_l, o[1] * inv_l); w.y = pk16(o[2] * inv_l, o[3] * inv_l);
            *(u32x2*)(orow + 64 * dc + 16 * dt) = w; }
        if (dc < 7) AT_WRITE((dc + 1) & 1);
        __syncthreads();
    }
#undef AT_LOAD
#undef AT_WRITE
}

__global__ void __launch_bounds__(512, 2) mk_fwd(Args a) {
    extern __shared__ __attribute__((aligned(16))) unsigned char lds_raw[];
    LAS unsigned char* lds = (LAS unsigned char*)lds_raw;
    volatile LAS unsigned* MISC = (volatile LAS unsigned*)(lds + MISC_OFF);
    const int G = gridDim.x, bx = blockIdx.x;
#define OPAQUE_TID() int tid = threadIdx.x; asm volatile("" : "+v"(tid)); const int lane = tid & 63, wave = __builtin_amdgcn_readfirstlane(tid >> 6); (void)lane; (void)wave
    const int vcu = (G % 8 == 0) ? (bx % 8) * (G / 8) + bx / 8 : bx;
    unsigned char* ws = a.ws;
    if (threadIdx.x < 64) MISC[threadIdx.x] = 0u;
    __syncthreads();
    XcdBarrier bar; bar.bar = (unsigned*)(ws + WS_CTL) + CW_BAR; bar.x = 0; bar.st = nullptr;
    if (!MK_PER_STEP) bar = xcd_barrier_post((unsigned*)(ws + WS_CTL) + CW_BAR, MISC + 8);

    float* H = a.out;
    f16_t* XA = (f16_t*)(ws + WS_XA); f16_t* XB = (f16_t*)(ws + WS_XB); f16_t* ACT = (f16_t*)(ws + WS_ACT);
    float* P1 = (float*)(ws + WS_PART1); float* P2 = (float*)(ws + WS_PART2); float* P3 = (float*)(ws + WS_PART3);

    for (int st = a.lo; st < a.hi; ++st) {
        if (st == ST_PREP) { OPAQUE_TID(); step_prep(a, lds, G, vcu, tid, wave, lane); }
        else if (st == ST_G1 || st == ST_G7) {
            pg8::Gemm g{XA, (const f16_t*)(ws + (st == ST_G1 ? WS_W1IN : WS_W2IN)), TROWS, 2 * DFF, DM}; pg8::StaticOrder S; S.init(TROWS, 2 * DFF, G, bx);
            pg8::EpiSwiGLU E{ACT, st == ST_G1 ? nullptr : P3};
            pg8::gemm_phase(lds, g, S, E);
        } else if (st == ST_G2 || st == ST_G4 || st == ST_G6 || st == ST_G8) {
            const f16_t* A; const f16_t* Bt; int K; const float* base; f16_t* HG; const float* gn; float* part; float alpha;
            if (st == ST_G2)      { A = ACT; Bt = (const f16_t*)(ws + WS_W1OUT);  K = DFF; base = inp(I_X); HG = XB;      gn = inp(I_GMIX);   part = P1;      alpha = 0.5f; }
            else if (st == ST_G4) { A = XA;  Bt = (const f16_t*)(ws + WS_WMIXOUT); K = DM;  base = H;         HG = XB;      gn = inp(I_GXATTN); part = P2;      alpha = 1.0f; }
            else if (st == ST_G6) { A = XB;  Bt = (const f16_t*)(ws + WS_WO);      K = DM;  base = H;         HG = XA;      gn = inp(I_GFFN2);  part = P3;      alpha = 1.0f; }
            else                  { A = ACT; Bt = (const f16_t*)(ws + WS_W2OUT);  K = DFF; base = H;         HG = nullptr; gn = nullptr;        part = nullptr; alpha = 0.5f; }
            pg8::Gemm g{A, Bt, TROWS, DM, K}; pg8::StaticOrder S; S.init(TROWS, DM, G, bx);
            pg8::EpiRes E{base, H, HG, gn, part, alpha};
            pg8::gemm_phase(lds, g, S, E);
        } else if (st == ST_G3 || st == ST_G5 || st == ST_KV) {
            const f16_t* A; const f16_t* Bt; int M, N, ldc, c; f16_t* O; const float* part; float scale;
            if (st == ST_G3)      { A = XB; Bt = (const f16_t*)(ws + WS_WMIXIN); M = TROWS; N = INC;    O = ACT; ldc = INC;    part = P1; scale = 1.0f; c = bx; }
            else if (st == ST_G5) { A = XB; Bt = (const f16_t*)(ws + WS_WQ);     M = TROWS; N = DM;     O = XA;  ldc = DM;     part = P2; scale = 0.04419417382f * 1.44269504089f; c = bx; }
            else                  { A = (const f16_t*)(ws + WS_MEMN); Bt = (const f16_t*)(ws + WS_WKV); M = MROWS; N = 2 * DM; O = (f16_t*)(ws + WS_KV); ldc = 2 * DM; part = nullptr; scale = 1.0f; c = (bx + G / 2) % G; }
            pg8::Gemm g{A, Bt, M, N, DM}; pg8::StaticOrder S; S.init(M, N, G, c);
            pg8::EpiF16 E{O, ldc, part, scale};
            pg8::gemm_phase(lds, g, S, E);
        } else if (st == ST_MIX) {
            OPAQUE_TID();
            for (int u = vcu; u < TROWS / 32; u += G) conv_unit(a, u, tid);
            for (int u = vcu; u < (TROWS / 128) * 8; u += G) gm_unit(a, lds, u, tid, wave, lane);
        } else if (st == ST_ATT) {
            OPAQUE_TID();
            for (int u = bx; u < NB * XH * (SEQ / 128); u += G) { const int pair = u & 7, qb = u >> 3; attn_unit(a, lds, pair >> 2, pair & 3, qb, tid, wave, lane); }
        } else if (st == ST_FIN) {
            OPAQUE_TID();
            const int gw = vcu * 8 + wave, NGW = G * 8;
            for (int m = gw; m < TROWS; m += NGW) {
                f32x4* xr = (f32x4*)(H + (size_t)m * DM) + lane; const f32x4* gr = (const f32x4*)inp(I_GFINAL) + lane;
                f32x4 v[8]; float s = 0.f;
#pragma unroll
                for (int j = 0; j < 8; ++j) { v[j] = xr[64 * j]; s += (v[j][0] * v[j][0] + v[j][1] * v[j][1]) + (v[j][2] * v[j][2] + v[j][3] * v[j][3]); }
                const float rs = __builtin_amdgcn_rsqf(wave_sum(s) * (1.f / DM) + EPS);
#pragma unroll
                for (int j = 0; j < 8; ++j) xr[64 * j] = v[j] * rs * gr[64 * j];
            }
        }
        if (!MK_PER_STEP && st + 1 < a.hi && st != ST_G3) xcd_barrier(bar);
    }
}


#ifndef MK_DEBUG
#define MK_DEBUG 0
#endif
#if MK_DEBUG
constexpr size_t WS_HOLD = 356 * MiB;
__device__ __forceinline__ unsigned hash32(unsigned x) { x ^= x >> 16; x *= 0x7feb352du; x ^= x >> 15; x *= 0x846ca68bu; x ^= x >> 16; return x; }
__device__ __forceinline__ float r16(float v) { return (float)(_Float16)v; }
__device__ __forceinline__ bool bad(float got, float ref) { return !(fabsf(got - ref) <= 0.02f * fabsf(ref) + 0.02f); }
__device__ __forceinline__ float rs_of_row(const float* H, int r) { float s = 0.f; for (int c = 0; c < DM; ++c) s += H[(size_t)r * DM + c] * H[(size_t)r * DM + c]; return 1.0f / sqrtf(s / DM + EPS); }
__global__ void chk_step(Args a, int st, unsigned* flags) {
    const unsigned char* ws = a.ws; const unsigned sid = blockIdx.x * blockDim.x + threadIdx.x; const unsigned h1 = hash32(sid * 2654435761u + 12345u + st * 977u), h2 = hash32(h1 + 0x9e3779b9u);
    const float* H = a.out; const float* HOLD = (const float*)(ws + WS_HOLD);
    const f16_t* XA = (const f16_t*)(ws + WS_XA); const f16_t* XB = (const f16_t*)(ws + WS_XB); const f16_t* ACT = (const f16_t*)(ws + WS_ACT);
    bool f = false;
    if (st == ST_PREP) {
        const int which = sid % 13;
        if (which < 10) {
            int ii, K, N; size_t off;
            switch (which) { case 0: ii = I_W1IN; K = DM; N = 2 * DFF; off = WS_W1IN; break; case 1: ii = I_W1OUT; K = DFF; N = DM; off = WS_W1OUT; break; case 2: ii = I_WMIXIN; K = DM; N = INC; off = WS_WMIXIN; break;
                case 3: ii = I_WMIXOUT; K = DM; N = DM; off = WS_WMIXOUT; break; case 4: ii = I_WQ; K = DM; N = DM; off = WS_WQ; break; case 5: ii = I_WK; K = DM; N = DM; off = WS_WKV; break;
                case 6: ii = I_WV; K = DM; N = DM; off = WS_WKV; break; case 7: ii = I_WO; K = DM; N = DM; off = WS_WO; break; case 8: ii = I_W2IN; K = DM; N = 2 * DFF; off = WS_W2IN; break; default: ii = I_W2OUT; K = DFF; N = DM; off = WS_W2OUT; break; }
            const float* Wsrc = a.in[0]; for (int q = 0; q < 23; ++q) if (q == ii) Wsrc = a.in[q];
            const int k = h1 % K, n = h2 % N; int row = n;
            if (which == 0 || which == 8) { const int up = n >= DFF, nn = n - up * DFF; row = (nn >> 7) * 256 + up * 128 + (nn & 127); }
            if (which == 6) row = n + DM;
            const float ref = r16(Wsrc[(size_t)k * N + n]), got = (float)((const f16_t*)(ws + off))[(size_t)row * K + k];
            f = !(fabsf(got - ref) <= 1e-6f);
        } else if (which == 10) { const int r = h1 % TROWS, c = h2 % DM; float s = 0.f; for (int j = 0; j < DM; ++j) { const float v = a.in[I_X][(size_t)r * DM + j]; s += v * v; }
            f = bad((float)XA[(size_t)r * DM + c], a.in[I_X][(size_t)r * DM + c] / sqrtf(s / DM + EPS) * a.in[I_GFFN1][c]);
        } else if (which == 11) { const int r = h1 % MROWS, c = h2 % DM; float s = 0.f; for (int j = 0; j < DM; ++j) { const float v = a.in[I_MEM][(size_t)r * DM + j]; s += v * v; }
            f = bad((float)((const f16_t*)(ws + WS_MEMN))[(size_t)r * DM + c], a.in[I_MEM][(size_t)r * DM + c] / sqrtf(s / DM + EPS) * a.in[I_GMEM][c]);
        } else { const int i = h1 % (8 * 128 * 128), t = (i >> 7) & 127, s = i & 127; f = bad((float)((const f16_t*)(ws + WS_WSP))[i], s <= t ? a.in[I_WSP][i] : 0.f); }
    } else if (st == ST_G1 || st == ST_G7) {
        const int r = h1 % TROWS, j = h2 % DFF; const float* W = a.in[st == ST_G1 ? I_W1IN : I_W2IN]; float g = 0.f, u = 0.f;
        for (int k = 0; k < DM; ++k) { const float x = (float)XA[(size_t)r * DM + k]; g += x * r16(W[(size_t)k * (2 * DFF) + j]); u += x * r16(W[(size_t)k * (2 * DFF) + DFF + j]); }
        if (st == ST_G7) { const float rs = rs_of_row(H, r); g *= rs; u *= rs; }
        f = bad((float)ACT[(size_t)r * DFF + j], g / (1.f + expf(-g)) * u);
    } else if (st == ST_G2 || st == ST_G4 || st == ST_G6 || st == ST_G8) {
        const int r = h1 % TROWS, c = h2 % DM; const f16_t* A; int K; const float* W; const float* base; const f16_t* HG; const float* gn; const float* part; float alpha;
        if (st == ST_G2)      { A = ACT; K = DFF; W = a.in[I_W1OUT];  base = a.in[I_X]; HG = XB; gn = a.in[I_GMIX];   part = (const float*)(ws + WS_PART1); alpha = 0.5f; }
        else if (st == ST_G4) { A = XA;  K = DM;  W = a.in[I_WMIXOUT]; base = HOLD;      HG = XB; gn = a.in[I_GXATTN]; part = (const float*)(ws + WS_PART2); alpha = 1.f; }
        else if (st == ST_G6) { A = XB;  K = DM;  W = a.in[I_WO];      base = HOLD;      HG = XA; gn = a.in[I_GFFN2];  part = (const float*)(ws + WS_PART3); alpha = 1.f; }
        else                  { A = ACT; K = DFF; W = a.in[I_W2OUT];  base = HOLD;      HG = nullptr; gn = nullptr; part = nullptr; alpha = 0.5f; }
        float s = 0.f; for (int k = 0; k < K; ++k) s += (float)A[(size_t)r * K + k] * r16(W[(size_t)k * DM + c]);
        const float ref = base[(size_t)r * DM + c] + alpha * s; f = bad(H[(size_t)r * DM + c], ref);
        if (HG) f = f || bad((float)HG[(size_t)r * DM + c], H[(size_t)r * DM + c] * gn[c]);
        if (part) { float ps = 0.f; for (int j = 0; j < NPART; ++j) ps += part[(size_t)r * NPART + j]; float hs = 0.f; for (int j = 0; j < DM; ++j) hs += H[(size_t)r * DM + j] * H[(size_t)r * DM + j]; f = f || bad(ps, hs); }
    } else if (st == ST_G3 || st == ST_G5) {
        const int N = st == ST_G3 ? INC : DM; const int r = h1 % TROWS, n = h2 % N; const float* W = a.in[st == ST_G3 ? I_WMIXIN : I_WQ]; const f16_t* O = st == ST_G3 ? ACT : XA;
        float s = 0.f; for (int k = 0; k < DM; ++k) s += (float)XB[(size_t)r * DM + k] * r16(W[(size_t)k * N + n]);
        s *= rs_of_row(H, r); if (st == ST_G5) s *= 0.04419417382f * 1.44269504089f;
        f = bad((float)O[(size_t)r * N + n], s);
    } else if (st == ST_KV) {
        const int r = h1 % MROWS, n = h2 % (2 * DM); const float* W = a.in[n < DM ? I_WK : I_WV]; const int nn = n % DM; const f16_t* MN = (const f16_t*)(ws + WS_MEMN);
        float s = 0.f; for (int k = 0; k < DM; ++k) s += (float)MN[(size_t)r * DM + k] * r16(W[(size_t)k * DM + nn]);
        f = bad((float)((const f16_t*)(ws + WS_KV))[(size_t)r * 2 * DM + n], s);
    } else if (st == ST_MIX) {
        const int r = h1 % TROWS, c = h2 % DM, t = r & (SEQ - 1); const f16_t* Z = ACT; float ref;
        if (c < CW) { float acc = a.in[I_CONVB][c];
            for (int k = 0; k < 3; ++k) { const int tt = t - 2 + k; if (tt >= 0) { const size_t rr = (size_t)(r - 2 + k) * INC; acc += a.in[I_CONVW][k * CW + c] * (float)Z[rr + CW + c] * (float)Z[rr + 2 * CW + c]; } }
            ref = (float)Z[(size_t)r * INC + c] * acc;
        } else { const int cc = c - CW, head = cc >> 7, R0 = r & ~127, tq = r & 127; float sg = a.in[I_BSP][head * 128 + tq];
            for (int s = 0; s <= tq; ++s) { float ss = 0.f; for (int j = 0; j < 128; ++j) { const float v = (float)Z[(size_t)(R0 + s) * INC + 4 * CW + head * 128 + j]; ss += v * v; }
                const float vn = (float)Z[(size_t)(R0 + s) * INC + 4 * CW + cc] / sqrtf(ss / 128.f + EPS) * a.in[I_GGMV][cc]; sg += a.in[I_WSP][(size_t)head * 128 * 128 + tq * 128 + s] * vn; }
            ref = (float)Z[(size_t)r * INC + 3 * CW + cc] * sg; }
        f = bad((float)XA[(size_t)r * DM + c], ref);
    } else if (st == ST_ATT) {
        const int r = h1 % TROWS, c = h2 % DM, hh = c / XHD, b = r / SEQ; const f16_t* KV = (const f16_t*)(ws + WS_KV);
        float mx = -1e30f;
        for (int m = 0; m < NMEM; ++m) { float s = 0.f; for (int d = 0; d < XHD; ++d) s += (float)XA[(size_t)r * DM + hh * XHD + d] * (float)KV[(size_t)(b * NMEM + m) * 2 * DM + hh * XHD + d]; mx = fmaxf(mx, s); }
        float l = 0.f, o = 0.f;
        for (int m = 0; m < NMEM; ++m) { float s = 0.f; for (int d = 0; d < XHD; ++d) s += (float)XA[(size_t)r * DM + hh * XHD + d] * (float)KV[(size_t)(b * NMEM + m) * 2 * DM + hh * XHD + d];
            const float p = exp2f(s - mx); l += p; o += p * (float)KV[(size_t)(b * NMEM + m) * 2 * DM + DM + c]; }
        f = bad((float)XB[(size_t)r * DM + c], o / l);
    } else if (st == ST_FIN) {
        const int r = h1 % TROWS, c = h2 % DM; f = bad(H[(size_t)r * DM + c], HOLD[(size_t)r * DM + c] * rs_of_row(HOLD, r) * a.in[I_GFINAL][c]);
    }
    if (f) atomicOr(flags, 1u << st);
}
__global__ void chk_final(float* out, const unsigned* flags) {
    const size_t i = (size_t)blockIdx.x * blockDim.x + threadIdx.x;
    if (i < (size_t)TROWS * DM) out[i] = 0.f;
    if (i == 0) { const unsigned fl = *flags; int code = 0; for (int s = ST_N - 1; s >= 0; --s) if ((fl >> s) & 1u) code = s + 1; out[0] = (10.f + code) * 100.f; }
}
#endif

extern "C" void kernel_launch(void* const* d_in, const int* in_sizes, int n_in, void* d_out, int out_size, void* d_ws, size_t ws_size, hipStream_t stream) {
    static int grid = 0;
    if (grid == 0) {
        if (n_in != 23 || in_sizes[0] != TROWS * DM || out_size != TROWS * DM || ws_size < WS_END + (MK_DEBUG ? 64 * MiB : 0)) {
            fprintf(stderr, "kernel_launch: built for 23 inputs, x/out of %d floats, >= %zu bytes of workspace; got n_in %d, in0 %d, out %d, ws %zu; nothing launched\n", TROWS * DM, (size_t)WS_END, n_in, n_in > 0 ? in_sizes[0] : -1, out_size, ws_size); grid = -1; return; }
        int dev = 0, cus = 0, per_cu = 0;
        if (hipGetDevice(&dev) != hipSuccess || hipDeviceGetAttribute(&cus, hipDeviceAttributeMultiprocessorCount, dev) != hipSuccess) { fprintf(stderr, "kernel_launch: device query failed\n"); grid = -1; return; }
        if (hipFuncSetAttribute((const void*)mk_fwd, hipFuncAttributeMaxDynamicSharedMemorySize, LDS_BYTES) != hipSuccess) { fprintf(stderr, "kernel_launch: hipFuncSetAttribute failed\n"); grid = -1; return; }
        if (hipOccupancyMaxActiveBlocksPerMultiprocessor(&per_cu, (const void*)mk_fwd, 512, LDS_BYTES) != hipSuccess || per_cu < 1) { fprintf(stderr, "kernel_launch: occupancy query reports %d blocks per CU; nothing launched\n", per_cu); (void)hipGetLastError(); grid = -1; return; }
        grid = cus;
    }
    if (grid < 0) return;
    if (hipMemsetAsync((char*)d_ws + WS_CTL, 0, CTL_ZERO_BYTES, stream) != hipSuccess) { fprintf(stderr, "kernel_launch: memset failed\n"); return; }
    Args a{};
    for (int i = 0; i < 23; ++i) a.in[i] = (const float*)d_in[i];
    a.out = (float*)d_out; a.ws = (unsigned char*)d_ws;
#if MK_PER_STEP
    for (int s = 0; s < ST_N; ++s) { a.lo = s; a.hi = s + 1;
#if MK_DEBUG
        if (s == ST_G4 || s == ST_G6 || s == ST_G8 || s == ST_FIN) (void)hipMemcpyAsync((char*)d_ws + WS_HOLD, d_out, (size_t)TROWS * DM * 4, hipMemcpyDeviceToDevice, stream);
#endif
        hipLaunchKernelGGL(mk_fwd, dim3(grid), dim3(512), LDS_BYTES, stream, a);
#if MK_DEBUG
        hipLaunchKernelGGL(chk_step, dim3(16), dim3(256), 0, stream, a, s, (unsigned*)d_ws + 64);
#endif
    }
#if MK_DEBUG
    hipLaunchKernelGGL(chk_final, dim3(TROWS * DM / 256), dim3(256), 0, stream, (float*)d_out, (const unsigned*)d_ws + 64);
#endif
#else
    a.lo = 0; a.hi = ST_N;
    hipLaunchKernelGGL(mk_fwd, dim3(grid), dim3(512), LDS_BYTES, stream, a);
#endif
    const hipError_t le = hipPeekAtLastError();
    if (le != hipSuccess) fprintf(stderr, "kernel_launch: launch failed: %s\n", hipGetErrorName(le));
}
```

```cpp
#include <hip/hip_runtime.h>
#include <cstdio>
#include <cstdint>

#ifndef MK_PER_STEP
#define MK_PER_STEP 0
#endif

#define LAS __attribute__((address_space(3)))
typedef _Float16 f16_t;
typedef _Float16 f16x8 __attribute__((ext_vector_type(8)));
typedef _Float16 f16x2 __attribute__((ext_vector_type(2)));
typedef __fp16 fp16x4v __attribute__((__vector_size__(4 * sizeof(__fp16))));
typedef float f32x4 __attribute__((ext_vector_type(4)));
typedef unsigned u32x4 __attribute__((ext_vector_type(4)));
typedef unsigned u32x2 __attribute__((ext_vector_type(2)));

constexpr int NB = 2, SEQ = 4096, DM = 2048, TROWS = NB * SEQ;
constexpr int DFF = 5632, INC = 5120, CW = 1024, GMW = 1024, NMEM = 256, MROWS = NB * NMEM;
constexpr int XH = 4, XHD = 512;
constexpr float EPS = 1e-6f;
constexpr int NPART = 32;

__device__ __forceinline__ unsigned pk16(float a, float b) { f16x2 v = {(_Float16)a, (_Float16)b}; return __builtin_bit_cast(unsigned, v); }
__device__ __forceinline__ f16x2 as_h2(unsigned u) { const unsigned t = u; return __builtin_bit_cast(f16x2, t); }

namespace pg8 {
constexpr int BM = 256, BK = 64, HALF = 128, HTB = HALF * BK * 2  , STAGE_BYTES = 8 * HTB, NXCD = 8, WGM = 8;
__host__ __device__ __forceinline__ int lds_byte(int r, int c) { const int st = (r >> 4) * 2 + (c >> 5), rr = r & 15, cc = c & 31, ob = rr * 64 + cc * 2; return st * 1024 + (ob ^ (((ob >> 9) & 1) << 5)); }
__host__ __device__ __forceinline__ void stage_rc(int b, int& R, int& C) { const int st = b / 1024, sb = b % 1024, swz = sb ^ (((sb >> 9) & 1) << 5); R = (st >> 1) * 16 + swz / 64; C = (st & 1) * 32 + (swz % 64) / 2; }
__host__ __device__ __forceinline__ int perm32(int rho) { const int n = rho >> 4, i = rho & 15; return 8 * (i >> 2) + 4 * n + (i & 3); }

struct Unit { int pm, pn; };
struct Gemm { const f16_t* A; const f16_t* Bt; int M, N, K; };

struct StaticOrder {
    int nM, nN, nwg, G, c;
    __device__ void init(int M, int N, int G_, int c_) { nM = M / BM; nN = N / BM; nwg = nM * nN; G = G_; c = c_; }
    __device__ bool next(int i, Unit& u) const {
        const long L = (long)i * G + c; if (L >= nwg) return false;
        int wgid = (int)L; { const int q = nwg / NXCD, r = nwg % NXCD, xcd = wgid % NXCD, off = wgid / NXCD; wgid = (xcd < r ? xcd * (q + 1) : r * (q + 1) + (xcd - r) * q) + off; }
        const int nig = WGM * nN, gid = wgid / nig, fm = gid * WGM, gsz = (nM - fm) < WGM ? (nM - fm) : WGM;
        u.pm = fm + ((wgid % nig) % gsz); u.pn = (wgid % nig) / gsz; return true;
    }
};

__device__ __forceinline__ void row_rs(const float* part, int pm, int wr, int lane, float (&rsv)[2]) {
#pragma unroll
    for (int ai = 0; ai < 2; ++ai) {
        const f32x4* p = (const f32x4*)(part + (size_t)(pm * BM + ai * HALF + wr * 64 + lane) * NPART);
        f32x4 s = p[0];
#pragma unroll
        for (int j = 1; j < NPART / 4; ++j) s += p[j];
        rsv[ai] = __builtin_amdgcn_rsqf(((s[0] + s[1]) + (s[2] + s[3])) * (1.0f / DM) + EPS);
    }
}

struct EpiF16 {
    f16_t* O; int ldc; const float* part; float scale;
    __device__ __forceinline__ void operator()(const f32x4 (&acc)[2][2][4][2], const Unit& u, int wr, int wc, int fr, int fq) const {
        const int lane = fq * 16 + fr; float rsv[2] = {1.f, 1.f};
        if (part) row_rs(part, u.pm, wr, lane, rsv);
        const int row0 = u.pm * BM + wr * 64 + fr, col0 = u.pn * BM + wc * 32 + 8 * fq;
#pragma unroll
        for (int ai = 0; ai < 2; ++ai)
#pragma unroll
            for (int m = 0; m < 4; ++m) {
                float s = scale; if (part) s *= __shfl(rsv[ai], m * 16 + fr);
                f16_t* rowp = O + (size_t)(row0 + ai * HALF + m * 16) * ldc + col0;
#pragma unroll
                for (int bj = 0; bj < 2; ++bj) { const f32x4 v0 = acc[ai][bj][m][0] * s, v1 = acc[ai][bj][m][1] * s;
                    u32x4 w; w.x = pk16(v0[0], v0[1]); w.y = pk16(v0[2], v0[3]); w.z = pk16(v1[0], v1[1]); w.w = pk16(v1[2], v1[3]);
                    *(u32x4*)(rowp + bj * HALF) = w; } }
    }
};
struct EpiSwiGLU {
    f16_t* O; const float* part;
    __device__ __forceinline__ void operator()(const f32x4 (&acc)[2][2][4][2], const Unit& u, int wr, int wc, int fr, int fq) const {
        const int lane = fq * 16 + fr; float rsv[2] = {1.f, 1.f};
        if (part) row_rs(part, u.pm, wr, lane, rsv);
        const int row0 = u.pm * BM + wr * 64 + fr, col0 = u.pn * HALF + wc * 32 + 8 * fq;
#pragma unroll
        for (int ai = 0; ai < 2; ++ai)
#pragma unroll
            for (int m = 0; m < 4; ++m) {
                float s = 1.f; if (part) s = __shfl(rsv[ai], m * 16 + fr);
                float o[8];
#pragma unroll
                for (int n = 0; n < 2; ++n)
#pragma unroll
                    for (int j = 0; j < 4; ++j) { const float g = acc[ai][0][m][n][j] * s, up = acc[ai][1][m][n][j] * s;
                        const float e = __builtin_amdgcn_exp2f(g * -1.44269504089f); o[n * 4 + j] = g * __builtin_amdgcn_rcpf(1.0f + e) * up; }
                u32x4 w; w.x = pk16(o[0], o[1]); w.y = pk16(o[2], o[3]); w.z = pk16(o[4], o[5]); w.w = pk16(o[6], o[7]);
                *(u32x4*)(O + (size_t)(row0 + ai * HALF + m * 16) * DFF + col0) = w; }
    }
};
struct EpiRes {
    const float* base; float* H; f16_t* HG; const float* g; float* part; float alpha;
    __device__ __forceinline__ void operator()(const f32x4 (&acc)[2][2][4][2], const Unit& u, int wr, int wc, int fr, int fq) const {
        const int row0 = u.pm * BM + wr * 64 + fr, col0 = u.pn * BM + wc * 32 + 8 * fq;
        f32x4 gv[2][2];
#pragma unroll
        for (int bj = 0; bj < 2; ++bj)
#pragma unroll
            for (int n = 0; n < 2; ++n) gv[bj][n] = HG ? *(const f32x4*)(g + col0 + bj * HALF + 4 * n) : (f32x4){0.f, 0.f, 0.f, 0.f};
#pragma unroll
        for (int ai = 0; ai < 2; ++ai)
#pragma unroll
            for (int m = 0; m < 4; ++m) {
                const int row = row0 + ai * HALF + m * 16; const size_t off = (size_t)row * DM + col0; float ss = 0.f;
#pragma unroll
                for (int bj = 0; bj < 2; ++bj) {
                    const f32x4 b0 = *(const f32x4*)(base + off + bj * HALF), b1 = *(const f32x4*)(base + off + bj * HALF + 4);
                    const f32x4 h0 = b0 + acc[ai][bj][m][0] * alpha, h1 = b1 + acc[ai][bj][m][1] * alpha;
                    *(f32x4*)(H + off + bj * HALF) = h0; *(f32x4*)(H + off + bj * HALF + 4) = h1;
                    ss += (h0[0] * h0[0] + h0[1] * h0[1]) + (h0[2] * h0[2] + h0[3] * h0[3]) + (h1[0] * h1[0] + h1[1] * h1[1]) + (h1[2] * h1[2] + h1[3] * h1[3]);
                    if (HG) { const f32x4 a = h0 * gv[bj][0], b = h1 * gv[bj][1];
                        u32x4 w; w.x = pk16(a[0], a[1]); w.y = pk16(a[2], a[3]); w.z = pk16(b[0], b[1]); w.w = pk16(b[2], b[3]);
                        *(u32x4*)(HG + off + bj * HALF) = w; } }
                ss += __shfl_xor(ss, 16); ss += __shfl_xor(ss, 32);
                if (part && fq == 0) part[(size_t)row * NPART + u.pn * 4 + wc] = ss;
                if (m & 1) asm volatile("" ::: "memory"); }
    }
};

template <class Epi>
__device__ __forceinline__ void gemm_phase(LAS unsigned char* lds, const Gemm g, const StaticOrder& S, const Epi& E) {
    int tid_ = threadIdx.x; asm volatile("" : "+v"(tid_));
    const int tid = tid_, wid = __builtin_amdgcn_readfirstlane(tid >> 6), lane = tid & 63, wr = wid >> 2, wc = wid & 3, fr = lane & 15, fq = lane >> 4;
    const int K = g.K, nt = K / BK;
    unsigned voffA[2], voffB[2];
#pragma unroll
    for (int i = 0; i < 2; ++i) { int R, C; stage_rc(tid * 16 + i * 8192, R, C); const int Rb = (R & ~31) + perm32(R & 31);
        voffA[i] = (unsigned)(R * K + C) * 2u; voffB[i] = (unsigned)(Rb * K + C) * 2u; }
    const size_t kstep = (size_t)(BK * 2);
    const size_t hstep = (size_t)HALF * K * 2;
    const size_t tstep = 2 * hstep;
    const unsigned ldsw = (unsigned)wid * 1024u;
    const int aoff = lds_byte(wr * 64 + fr, fq * 8), boff = lds_byte(wc * 32 + fr, fq * 8);
#define PG8_SA(b, h) (((b) * 2 + (h)) * HTB)
#define PG8_SB(b, h) ((4 + (b) * 2 + (h)) * HTB)
#define PG8_STAGE(bufoff, gbase, voff) do { _Pragma("unroll") for (int _i = 0; _i < 2; ++_i) \
        __builtin_amdgcn_global_load_lds((const unsigned*)((const char*)(gbase) + (voff)[_i]), (LAS unsigned*)(lds + (bufoff) + ldsw + _i * 8192), 16, 0, 0); } while (0)
#define PG8_LDA(dst, b, h) do { _Pragma("unroll") for (int m = 0; m < 4; ++m) _Pragma("unroll") for (int k = 0; k < 2; ++k) dst[m][k] = *(const LAS f16x8*)(lds + PG8_SA(b, h) + aoff + m * 2048 + k * 1024); } while (0)
#define PG8_LDB(dst, b, h) do { _Pragma("unroll") for (int n = 0; n < 2; ++n) _Pragma("unroll") for (int k = 0; k < 2; ++k) dst[n][k] = *(const LAS f16x8*)(lds + PG8_SB(b, h) + boff + n * 2048 + k * 1024); } while (0)
#define PG8_MMA(ai, bj, At, Bt) do { __builtin_amdgcn_s_setprio(1); _Pragma("unroll") for (int m = 0; m < 4; ++m) _Pragma("unroll") for (int n = 0; n < 2; ++n) _Pragma("unroll") for (int k = 0; k < 2; ++k) \
        acc[ai][bj][m][n] = __builtin_amdgcn_mfma_f32_16x16x32_f16(Bt[n][k], At[m][k], acc[ai][bj][m][n], 0, 0, 0); __builtin_amdgcn_s_setprio(0); } while (0)
#define PG8_WAIT_V(n) asm volatile("s_waitcnt vmcnt(" #n ")" ::: "memory")
#define PG8_WAIT_L(n) asm volatile("s_waitcnt lgkmcnt(" #n ")" ::: "memory")
#define PG8_BAR __builtin_amdgcn_s_barrier()
#define PG8_SCHED __builtin_amdgcn_sched_barrier(0)
    Unit cur, nxt; int ui = 0;
    if (!S.next(0, cur)) return;
    f32x4 acc[2][2][4][2];
#pragma unroll
    for (int a = 0; a < 2; ++a)
#pragma unroll
        for (int b = 0; b < 2; ++b)
#pragma unroll
            for (int m = 0; m < 4; ++m)
#pragma unroll
                for (int n = 0; n < 2; ++n) acc[a][b][m][n] = (f32x4){0.f, 0.f, 0.f, 0.f};
    f16x8 At[4][2], B0[2][2], B1[2][2];
    const char* cA = (const char*)g.A + (size_t)cur.pm * tstep; const char* cB = (const char*)g.Bt + (size_t)cur.pn * tstep;
    PG8_STAGE(PG8_SB(0, 0), cB, voffB); PG8_STAGE(PG8_SB(0, 1), cB + hstep, voffB); PG8_STAGE(PG8_SA(0, 0), cA, voffA); PG8_STAGE(PG8_SA(0, 1), cA + hstep, voffA);
    if (wr == 1) PG8_BAR;
    PG8_WAIT_V(2); PG8_BAR;
    PG8_STAGE(PG8_SB(1, 0), cB + kstep, voffB); PG8_STAGE(PG8_SA(1, 0), cA + kstep, voffA); PG8_STAGE(PG8_SB(1, 1), cB + hstep + kstep, voffB);
    PG8_WAIT_V(6); PG8_BAR;
    for (;;) {
        const bool has_next = S.next(ui + 1, nxt);
        const char* nA = has_next ? (const char*)g.A + (size_t)nxt.pm * tstep : cA; const char* nB = has_next ? (const char*)g.Bt + (size_t)nxt.pn * tstep : cB;
        for (int t = 0; t < nt; t += 2) {
            const bool last = (t == nt - 2);
            const char* a1 = cA + (size_t)(t + 1) * kstep;
            const char* a2 = last ? nA : cA + (size_t)(t + 2) * kstep; const char* b2 = last ? nB : cB + (size_t)(t + 2) * kstep;
            const char* a3 = a2 + kstep; const char* b3 = b2 + kstep;
            PG8_LDB(B0, 0, 0); PG8_LDB(B1, 0, 1); PG8_SCHED; PG8_LDA(At, 0, 0); PG8_STAGE(PG8_SA(1, 1), a1 + hstep, voffA);
            PG8_WAIT_V(8); PG8_WAIT_L(0); PG8_BAR; PG8_MMA(0, 0, At, B0); PG8_MMA(0, 1, At, B1); PG8_BAR; PG8_SCHED;
            PG8_LDA(At, 0, 1); PG8_STAGE(PG8_SB(0, 0), b2, voffB); PG8_STAGE(PG8_SB(0, 1), b2 + hstep, voffB); PG8_STAGE(PG8_SA(0, 0), a2, voffA);
            PG8_WAIT_V(8); PG8_WAIT_L(0); PG8_BAR; PG8_MMA(1, 0, At, B0); PG8_MMA(1, 1, At, B1); PG8_BAR; PG8_SCHED;
            PG8_LDB(B0, 1, 0); PG8_LDB(B1, 1, 1); PG8_SCHED; PG8_LDA(At, 1, 0); PG8_STAGE(PG8_SA(0, 1), a2 + hstep, voffA);
            PG8_WAIT_V(8); PG8_WAIT_L(0); PG8_BAR; PG8_MMA(0, 0, At, B0); PG8_MMA(0, 1, At, B1); PG8_BAR; PG8_SCHED;
            PG8_LDA(At, 1, 1); PG8_STAGE(PG8_SB(1, 0), b3, voffB); PG8_STAGE(PG8_SB(1, 1), b3 + hstep, voffB); PG8_STAGE(PG8_SA(1, 0), a3, voffA);
            PG8_WAIT_V(8); PG8_WAIT_L(0); PG8_BAR; PG8_MMA(1, 0, At, B0); PG8_MMA(1, 1, At, B1); PG8_BAR; PG8_SCHED;
        }
        if (wr == 0) PG8_BAR;
        E(acc, cur, wr, wc, fr, fq);
        if (!has_next) break;
#pragma unroll
        for (int a = 0; a < 2; ++a)
#pragma unroll
            for (int b = 0; b < 2; ++b)
#pragma unroll
                for (int m = 0; m < 4; ++m)
#pragma unroll
                    for (int n = 0; n < 2; ++n) acc[a][b][m][n] = (f32x4){0.f, 0.f, 0.f, 0.f};
        cur = nxt; cA = nA; cB = nB; ++ui;
        if (wr == 1) PG8_BAR;
    }
    PG8_WAIT_V(0);
    PG8_BAR;
#undef PG8_SA
#undef PG8_SB
#undef PG8_STAGE
#undef PG8_LDA
#undef PG8_LDB
#undef PG8_MMA
#undef PG8_WAIT_V
#undef PG8_WAIT_L
#undef PG8_BAR
#undef PG8_SCHED
}
}

constexpr size_t MiB = 1u << 20;
constexpr size_t WS_CTL = 0, CTL_ZERO_BYTES = 64 * 1024;
constexpr size_t WS_PART1 = 1 * MiB, WS_PART2 = 2 * MiB, WS_PART3 = 3 * MiB;
constexpr size_t WS_WSP = 4 * MiB;
constexpr size_t WS_MEMN = 5 * MiB;
constexpr size_t WS_KV = 7 * MiB;
constexpr size_t WS_W1IN = 12 * MiB, WS_W1OUT = 56 * MiB, WS_WMIXIN = 78 * MiB, WS_WMIXOUT = 98 * MiB, WS_WQ = 106 * MiB, WS_WKV = 114 * MiB,
                 WS_WO = 130 * MiB, WS_W2IN = 138 * MiB, WS_W2OUT = 182 * MiB;
constexpr size_t WS_XA = 204 * MiB, WS_XB = 236 * MiB;
constexpr size_t WS_ACT = 268 * MiB;
constexpr size_t WS_END = 356 * MiB;
constexpr int CW_BAR = 4096;

constexpr int RING_BYTES = 131072;
constexpr int MISC_OFF = RING_BYTES;
constexpr int LDS_BYTES = 147456;

#define XB_TMO      128
#define XB_XCNT(j)  (256  + 64 * (j))
#define XB_XSUB(j)  (1280 + 64 * (j))
#define XB_XGEN(j)  (2304 + 64 * (j))
#define XB_TOP      3328
#define XB_TOPGEN   3392
#define XCD_BAR_WORDS 3456
#define XB_SPIN_CAP (1u << 20)
__device__ __forceinline__ unsigned xb_ld(unsigned* p)              { return __hip_atomic_load(p, __ATOMIC_RELAXED, __HIP_MEMORY_SCOPE_AGENT); }
__device__ __forceinline__ unsigned xb_add(unsigned* p, unsigned v) { return __hip_atomic_fetch_add(p, v, __ATOMIC_RELAXED, __HIP_MEMORY_SCOPE_AGENT); }
__device__ __forceinline__ unsigned xb_xcc_id() { return (unsigned)__builtin_amdgcn_s_getreg((3 << 11) | 20) & 0xFu; }
#define XB_SPIN(cond, bar) do { unsigned _sp = 0; while (cond) { __builtin_amdgcn_s_sleep(1); \
    if ((++_sp & 255u) == 0u) { if (xb_ld(&(bar)[XB_TMO])) break; if (_sp > XB_SPIN_CAP) { atomicAdd(&(bar)[XB_TMO], 1u); break; } } } } while (0)
struct XcdBarrier { unsigned* bar; unsigned x; volatile LAS unsigned* st; };
__device__ __forceinline__ XcdBarrier xcd_barrier_post(unsigned* bar, volatile LAS unsigned* st) {
    XcdBarrier b; b.bar = bar; b.x = xb_xcc_id(); b.st = st;
    if (threadIdx.x == 0) (void)xb_add(&bar[XB_XCNT(b.x)], 1u);
    return b;
}
__device__ __forceinline__ void xcd_barrier_complete(unsigned* bar, unsigned x, unsigned& nloc, unsigned& nx) {
    const unsigned G = gridDim.x * gridDim.y * gridDim.z;
    unsigned sum, cnt, mine, sp = 0u;
    for (;;) {
        sum = 0u; cnt = 0u; mine = 0u;
#pragma unroll
        for (unsigned j = 0; j < 16; ++j) { const unsigned c = xb_ld(&bar[XB_XCNT(j)]); sum += c; cnt += (c > 0u) ? 1u : 0u; mine = (j == x) ? c : mine; }
        if (sum == G) break;
        __builtin_amdgcn_s_sleep(1);
        if ((++sp & 255u) == 0u) { if (xb_ld(&bar[XB_TMO])) break; if (sp > XB_SPIN_CAP) { atomicAdd(&bar[XB_TMO], 1u); break; } }
    }
    nloc = mine > 0u ? mine : 1u; nx = cnt > 0u ? cnt : 1u;
}
__device__ __forceinline__ void xcd_barrier(const XcdBarrier& b) {
    asm volatile("s_waitcnt vmcnt(0)" ::: "memory");
    __syncthreads();
    if (threadIdx.x == 0) {
        unsigned* bar = b.bar;
        __builtin_amdgcn_s_waitcnt(0);
        unsigned nloc = b.st[0], nx = b.st[1];
        if (nloc == 0u) { xcd_barrier_complete(bar, b.x, nloc, nx); b.st[0] = nloc; b.st[1] = nx; }
        const unsigned old = xb_add(&bar[XB_XSUB(b.x)], 1u);
        const unsigned gen = old / nloc;
        if (old + 1u == (gen + 1u) * nloc) {
            __builtin_amdgcn_fence(__ATOMIC_RELEASE, "agent");
            asm volatile("s_waitcnt vmcnt(0)" ::: "memory");
            const unsigned og = xb_add(&bar[XB_TOP], 1u);
            const unsigned tg = og / nx;
            if (og + 1u == (tg + 1u) * nx) xb_add(&bar[XB_TOPGEN], 1u);
            else XB_SPIN(xb_ld(&bar[XB_TOPGEN]) == tg, bar);
            __builtin_amdgcn_fence(__ATOMIC_ACQUIRE, "agent");
            xb_add(&bar[XB_XGEN(b.x)], 1u);
            asm volatile("s_waitcnt vmcnt(0)" ::: "memory");
        } else {
            XB_SPIN(xb_ld(&bar[XB_XGEN(b.x)]) == gen, bar);
            __builtin_amdgcn_fence(__ATOMIC_ACQUIRE, "agent");
            asm volatile("s_waitcnt vmcnt(0)" ::: "memory");
        }
    }
    __syncthreads();
}

#define LDS_WAIT() asm volatile("s_waitcnt lgkmcnt(0)" ::: "memory")
__device__ __forceinline__ float wave_sum(float v) {
#pragma unroll
    for (int o = 1; o < 64; o <<= 1) v += __shfl_xor(v, o);
    return v;
}
__device__ __forceinline__ void transpose_item(const float* W, int N, f16_t* WT, int K, int dst_row0, int k0, int n0, LAS float* scr, int lane) {
#pragma unroll 8
    for (int i = 0; i < 32; ++i) { const int kk = 2 * i + (lane >> 5); scr[kk * 33 + (lane & 31)] = W[(size_t)(k0 + kk) * N + n0 + (lane & 31)]; }
    LDS_WAIT(); asm volatile("" ::: "memory");
    const int c = lane & 7;
#pragma unroll
    for (int j = 0; j < 4; ++j) { const int n = (lane >> 3) + 8 * j; const LAS float* s = scr + (8 * c) * 33 + n;
        u32x4 o; o.x = pk16(s[0 * 33], s[1 * 33]); o.y = pk16(s[2 * 33], s[3 * 33]); o.z = pk16(s[4 * 33], s[5 * 33]); o.w = pk16(s[6 * 33], s[7 * 33]);
        *(u32x4*)(WT + (size_t)(dst_row0 + n) * K + k0 + 8 * c) = o; }
    LDS_WAIT(); asm volatile("" ::: "memory");
}
__device__ __forceinline__ void prep_mat(const float* W, int K, int N, f16_t* WT, int row_off, bool ileave, int r, LAS float* scr, int lane) {
    const int nblk = N / 32, kb = r / nblk, nb = r - kb * nblk, n0 = 32 * nb;
    int dr;
    if (ileave) { const int half = N / 2, up = n0 >= half ? 1 : 0, nn = n0 - up * half; dr = (nn >> 7) * 256 + up * 128 + (nn & 127); } else dr = row_off + n0;
    transpose_item(W, N, WT, K, dr, 64 * kb, n0, scr, lane);
}
__device__ __forceinline__ void norm_row_f16(const float* xrow, const float* g, f16_t* orow, int lane) {
    const f32x4* xr = (const f32x4*)xrow + lane; const f32x4* gr = (const f32x4*)g + lane;
    f32x4 v[8]; float s = 0.f;
#pragma unroll
    for (int j = 0; j < 8; ++j) { v[j] = xr[64 * j]; s += (v[j][0] * v[j][0] + v[j][1] * v[j][1]) + (v[j][2] * v[j][2] + v[j][3] * v[j][3]); }
    const float rs = __builtin_amdgcn_rsqf(wave_sum(s) * (1.f / DM) + EPS);
    u32x2* o8 = (u32x2*)orow + lane;
#pragma unroll
    for (int j = 0; j < 8; ++j) { const f32x4 gg = gr[64 * j]; u32x2 w; w.x = pk16(v[j][0] * rs * gg[0], v[j][1] * rs * gg[1]); w.y = pk16(v[j][2] * rs * gg[2], v[j][3] * rs * gg[3]); o8[64 * j] = w; }
}

struct Args { const float* in[23]; float* out; unsigned char* ws; int lo, hi; };
__device__ __forceinline__ const float* inp(int i) {
    const __attribute__((address_space(4))) unsigned long long* t = (const __attribute__((address_space(4))) unsigned long long*)__builtin_amdgcn_kernarg_segment_ptr();
    asm volatile("" : "+s"(i));
    return (const float*)t[i];
}
enum { I_X = 0, I_MEM, I_GFFN1, I_W1IN, I_W1OUT, I_GMIX, I_WMIXIN, I_CONVW, I_CONVB, I_GGMV, I_WSP, I_BSP, I_WMIXOUT, I_GXATTN, I_GMEM, I_WQ, I_WK, I_WV, I_WO, I_GFFN2, I_W2IN, I_W2OUT, I_GFINAL };
enum { ST_PREP = 0, ST_G1, ST_G2, ST_G3, ST_KV, ST_MIX, ST_G4, ST_G5, ST_ATT, ST_G6, ST_G7, ST_G8, ST_FIN, ST_N };

__device__ __forceinline__ void step_prep(const Args& a, LAS unsigned char* lds, int G, int vcu, int tid, int wave, int lane) {
    unsigned char* ws = a.ws;
    LAS float* scr = (LAS float*)(lds + wave * 16384);
    const int gw = vcu * 8 + wave, NGW = G * 8;
    constexpr int I_FIN = (DM / 64) * (2 * DFF / 32), I_FOUT = (DFF / 64) * (DM / 32), I_MIXIN = (DM / 64) * (INC / 32), I_SQ = (DM / 64) * (DM / 32);
    constexpr int NITEMS = 2 * I_FIN + 2 * I_FOUT + I_MIXIN + 5 * I_SQ;
    for (int it = gw; it < NITEMS; it += NGW) {
        int r = it;
        if (r < I_FIN) { prep_mat(inp(I_W1IN), DM, 2 * DFF, (f16_t*)(ws + WS_W1IN), 0, true, r, scr, lane); continue; } r -= I_FIN;
        if (r < I_FOUT) { prep_mat(inp(I_W1OUT), DFF, DM, (f16_t*)(ws + WS_W1OUT), 0, false, r, scr, lane); continue; } r -= I_FOUT;
        if (r < I_MIXIN) { prep_mat(inp(I_WMIXIN), DM, INC, (f16_t*)(ws + WS_WMIXIN), 0, false, r, scr, lane); continue; } r -= I_MIXIN;
        if (r < I_SQ) { prep_mat(inp(I_WMIXOUT), DM, DM, (f16_t*)(ws + WS_WMIXOUT), 0, false, r, scr, lane); continue; } r -= I_SQ;
        if (r < I_SQ) { prep_mat(inp(I_WQ), DM, DM, (f16_t*)(ws + WS_WQ), 0, false, r, scr, lane); continue; } r -= I_SQ;
        if (r < I_SQ) { prep_mat(inp(I_WK), DM, DM, (f16_t*)(ws + WS_WKV), 0, false, r, scr, lane); continue; } r -= I_SQ;
        if (r < I_SQ) { prep_mat(inp(I_WV), DM, DM, (f16_t*)(ws + WS_WKV), DM, false, r, scr, lane); continue; } r -= I_SQ;
        if (r < I_SQ) { prep_mat(inp(I_WO), DM, DM, (f16_t*)(ws + WS_WO), 0, false, r, scr, lane); continue; } r -= I_SQ;
        if (r < I_FIN) { prep_mat(inp(I_W2IN), DM, 2 * DFF, (f16_t*)(ws + WS_W2IN), 0, true, r, scr, lane); continue; } r -= I_FIN;
        prep_mat(inp(I_W2OUT), DFF, DM, (f16_t*)(ws + WS_W2OUT), 0, false, r, scr, lane);
    }
    for (int m = gw; m < TROWS; m += NGW) norm_row_f16(inp(I_X) + (size_t)m * DM, inp(I_GFFN1), (f16_t*)(ws + WS_XA) + (size_t)m * DM, lane);
    for (int m = gw; m < MROWS; m += NGW) norm_row_f16(inp(I_MEM) + (size_t)m * DM, inp(I_GMEM), (f16_t*)(ws + WS_MEMN) + (size_t)m * DM, lane);
    { const f32x4* src = (const f32x4*)inp(I_WSP); u32x2* dst = (u32x2*)(ws + WS_WSP);
      for (int i = vcu * 512 + tid; i < 8 * 128 * 128 / 4; i += G * 512) { const int t = (i >> 5) & 127, s0 = (i & 31) * 4; const f32x4 v = src[i];
          u32x2 w; w.x = pk16(s0 <= t ? v[0] : 0.f, s0 + 1 <= t ? v[1] : 0.f); w.y = pk16(s0 + 2 <= t ? v[2] : 0.f, s0 + 3 <= t ? v[3] : 0.f); dst[i] = w; } }
}

__device__ __forceinline__ void f16x8_to_f32(const u32x4 w, float (&f)[8]) {
#pragma unroll
    for (int j = 0; j < 4; ++j) { const f16x2 h = as_h2(w[j]); f[2 * j] = (float)h[0]; f[2 * j + 1] = (float)h[1]; }
}
__device__ __forceinline__ void conv_unit(const Args& a, int cu, int tid) {
    const f16_t* Z = (const f16_t*)(a.ws + WS_ACT); f16_t* Y = (f16_t*)(a.ws + WS_XA);
    const int cg = tid & 127, rg = tid >> 7, c = 8 * cg, r0 = 32 * cu + 8 * rg;
    float w0[8], w1[8], w2[8], cb[8];
    { const f32x4* p = (const f32x4*)(inp(I_CONVW) + c); const f32x4 a0 = p[0], a1 = p[1], b0 = p[CW / 4], b1 = p[CW / 4 + 1], c0 = p[2 * CW / 4], c1 = p[2 * CW / 4 + 1];
      const f32x4* q = (const f32x4*)(inp(I_CONVB) + c); const f32x4 d0 = q[0], d1 = q[1];
#pragma unroll
      for (int j = 0; j < 4; ++j) { w0[j] = a0[j]; w0[4 + j] = a1[j]; w1[j] = b0[j]; w1[4 + j] = b1[j]; w2[j] = c0[j]; w2[4 + j] = c1[j]; cb[j] = d0[j]; cb[4 + j] = d1[j]; } }
    float m2[8], m1[8];
    const bool first = (r0 & (SEQ - 1)) == 0;
    {
        float x[8], y[8];
        if (!first) {
            f16x8_to_f32(*(const u32x4*)(Z + (size_t)(r0 - 2) * INC + CW + c), x); f16x8_to_f32(*(const u32x4*)(Z + (size_t)(r0 - 2) * INC + 2 * CW + c), y);
#pragma unroll
            for (int j = 0; j < 8; ++j) m2[j] = x[j] * y[j];
            f16x8_to_f32(*(const u32x4*)(Z + (size_t)(r0 - 1) * INC + CW + c), x); f16x8_to_f32(*(const u32x4*)(Z + (size_t)(r0 - 1) * INC + 2 * CW + c), y);
#pragma unroll
            for (int j = 0; j < 8; ++j) m1[j] = x[j] * y[j];
        } else {
#pragma unroll
            for (int j = 0; j < 8; ++j) { m2[j] = 0.f; m1[j] = 0.f; }
        }
    }
#pragma unroll
    for (int rr = 0; rr < 8; ++rr) {
        const size_t ro = (size_t)(r0 + rr) * INC + c;
        float gb[8], gc[8], hc[8], o[8];
        f16x8_to_f32(*(const u32x4*)(Z + ro), gb); f16x8_to_f32(*(const u32x4*)(Z + ro + CW), gc); f16x8_to_f32(*(const u32x4*)(Z + ro + 2 * CW), hc);
#pragma unroll
        for (int j = 0; j < 8; ++j) { const float ch = gc[j] * hc[j]; o[j] = gb[j] * (cb[j] + w2[j] * ch + w1[j] * m1[j] + w0[j] * m2[j]); m2[j] = m1[j]; m1[j] = ch; }
        u32x4 w; w.x = pk16(o[0], o[1]); w.y = pk16(o[2], o[3]); w.z = pk16(o[4], o[5]); w.w = pk16(o[6], o[7]);
        *(u32x4*)(Y + (size_t)(r0 + rr) * DM + c) = w;
    }
}
constexpr int VNT_PITCH = 272;
__device__ __forceinline__ void gm_unit(const Args& a, LAS unsigned char* lds, int gu, int tid, int wave, int lane) {
    const f16_t* Z = (const f16_t*)(a.ws + WS_ACT); f16_t* Y = (f16_t*)(a.ws + WS_XA); const f16_t* WSP = (const f16_t*)(a.ws + WS_WSP);
    const int head = gu & 7, R0 = (gu >> 3) * 128;
    { const int ch = tid & 15, sr = tid >> 4; float gg[8];
      { const f32x4* p = (const f32x4*)(inp(I_GGMV) + head * 128 + 8 * ch); const f32x4 g0 = p[0], g1 = p[1];
#pragma unroll
        for (int j = 0; j < 4; ++j) { gg[j] = g0[j]; gg[4 + j] = g1[j]; } }
#pragma unroll
      for (int ps = 0; ps < 4; ++ps) { const int s = sr + 32 * ps; float v[8];
          f16x8_to_f32(*(const u32x4*)(Z + (size_t)(R0 + s) * INC + 4 * CW + head * 128 + 8 * ch), v);
          float ss = 0.f;
#pragma unroll
          for (int j = 0; j < 8; ++j) ss += v[j] * v[j];
          ss += __shfl_xor(ss, 1); ss += __shfl_xor(ss, 2); ss += __shfl_xor(ss, 4); ss += __shfl_xor(ss, 8);
          const float rs = __builtin_amdgcn_rsqf(ss * (1.f / 128.f) + EPS);
#pragma unroll
          for (int j = 0; j < 8; ++j) *(LAS f16_t*)(lds + (8 * ch + j) * VNT_PITCH + 2 * s) = (f16_t)(v[j] * rs * gg[j]); } }
    __syncthreads();
    const int fr = lane & 15, g = lane >> 4;
    f16x8 Af[4];
#pragma unroll
    for (int ks = 0; ks < 4; ++ks) Af[ks] = *(const LAS f16x8*)(lds + (16 * wave + fr) * VNT_PITCH + (32 * ks + 8 * g) * 2);
    f32x4 acc[8];
    const f16_t* wrow = WSP + (size_t)head * 128 * 128 + (size_t)fr * 128 + 8 * g;
#pragma unroll
    for (int tb = 0; tb < 8; ++tb) { acc[tb] = (f32x4){0.f, 0.f, 0.f, 0.f};
#pragma unroll
        for (int ks = 0; ks < 4; ++ks) if (32 * ks <= 16 * tb + 15) { const f16x8 Bf = *(const f16x8*)(wrow + (size_t)tb * 16 * 128 + 32 * ks);
            acc[tb] = __builtin_amdgcn_mfma_f32_16x16x32_f16(Af[ks], Bf, acc[tb], 0, 0, 0); } }
#pragma unroll
    for (int tb = 0; tb < 8; ++tb) { const int t = 16 * tb + fr; const float bs = inp(I_BSP)[head * 128 + t];
        const size_t ro = (size_t)(R0 + t); const int cc = head * 128 + 16 * wave + 4 * g;
        const u32x2 uw = *(const u32x2*)(Z + ro * INC + 3 * CW + cc); const f16x2 u0 = as_h2(uw.x), u1 = as_h2(uw.y);
        u32x2 w; w.x = pk16((float)u0[0] * (acc[tb][0] + bs), (float)u0[1] * (acc[tb][1] + bs)); w.y = pk16((float)u1[0] * (acc[tb][2] + bs), (float)u1[1] * (acc[tb][3] + bs));
        *(u32x2*)(Y + ro * DM + CW + cc) = w; }
    __syncthreads();
}

__device__ __forceinline__ void attn_unit(const Args& a, LAS unsigned char* lds, int b, int h, int qb, int tid, int wave, int lane) {
    const f16_t* Q = (const f16_t*)(a.ws + WS_XA); const f16_t* KV = (const f16_t*)(a.ws + WS_KV); f16_t* O = (f16_t*)(a.ws + WS_XB);
    const int fr = lane & 15, g = lane >> 4;
    const int R0 = b * SEQ + qb * 128 + wave * 16;
    f16x8 Qf[16];
    { const f16_t* qp = Q + (size_t)(R0 + fr) * DM + h * XHD + 8 * g;
#pragma unroll
      for (int kk = 0; kk < 16; ++kk) Qf[kk] = *(const f16x8*)(qp + 32 * kk); }
    const int srow = tid >> 3, sc = tid & 7;
    const f16_t* kbase = KV + (size_t)(b * NMEM + srow) * (2 * DM) + h * XHD + sc * 8;
    const unsigned swoff = (unsigned)(srow * 128 + ((sc ^ (srow & 7)) << 4));
    u32x4 st[4];
#define AT_LOAD(c) do { const f16_t* _p = kbase + ((c) >= 8 ? DM : 0) + 64 * ((c) & 7); _Pragma("unroll") for (int _i = 0; _i < 4; ++_i) st[_i] = *(const u32x4*)(_p + (size_t)_i * 64 * (2 * DM)); } while (0)
#define AT_WRITE(buf) do { _Pragma("unroll") for (int _i = 0; _i < 4; ++_i) *(LAS u32x4*)(lds + (buf) * 32768 + swoff + _i * 8192) = st[_i]; } while (0)
    AT_LOAD(0); AT_WRITE(0); __syncthreads();
    f32x4 S[16];
#pragma unroll
    for (int i = 0; i < 16; ++i) S[i] = (f32x4){0.f, 0.f, 0.f, 0.f};
    unsigned aoffK[2];
#pragma unroll
    for (int ks = 0; ks < 2; ++ks) aoffK[ks] = (unsigned)(fr * 128 + (((4 * ks + g) ^ (fr & 7)) << 4));
#pragma unroll
    for (int dc = 0; dc < 8; ++dc) {
        AT_LOAD(dc + 1);
        const LAS unsigned char* bp = lds + (dc & 1) * 32768;
#pragma unroll
        for (int mt = 0; mt < 16; ++mt)
#pragma unroll
            for (int ks = 0; ks < 2; ++ks) S[mt] = __builtin_amdgcn_mfma_f32_16x16x32_f16(*(const LAS f16x8*)(bp + mt * 2048 + aoffK[ks]), Qf[2 * dc + ks], S[mt], 0, 0, 0);
        AT_WRITE((dc + 1) & 1); __syncthreads();
    }
    float mx = S[0][0];
#pragma unroll
    for (int i = 0; i < 16; ++i) mx = fmaxf(fmaxf(mx, fmaxf(S[i][0], S[i][1])), fmaxf(S[i][2], S[i][3]));
    mx = fmaxf(mx, __shfl_xor(mx, 16)); mx = fmaxf(mx, __shfl_xor(mx, 32));
    float l = 0.f;
#pragma unroll
    for (int i = 0; i < 16; ++i)
#pragma unroll
        for (int r = 0; r < 4; ++r) { const float p = __builtin_amdgcn_exp2f(S[i][r] - mx); S[i][r] = p; l += p; }
    l += __shfl_xor(l, 16); l += __shfl_xor(l, 32);
    const float inv_l = 1.0f / l;
    f16x8 Pf[8];
#pragma unroll
    for (int ks = 0; ks < 8; ++ks) { u32x4 w; w.x = pk16(S[2 * ks][0], S[2 * ks][1]); w.y = pk16(S[2 * ks][2], S[2 * ks][3]); w.z = pk16(S[2 * ks + 1][0], S[2 * ks + 1][1]); w.w = pk16(S[2 * ks + 1][2], S[2 * ks + 1][3]);
        Pf[ks] = __builtin_bit_cast(f16x8, w); }
    const int q4 = fr >> 2, p4 = fr & 3;
    unsigned voff[4];
#pragma unroll
    for (int dt = 0; dt < 4; ++dt) voff[dt] = (unsigned)((4 * g + q4) * 128 + (((2 * dt + (p4 >> 1)) ^ (((g & 1) << 2) + q4)) << 4) + (p4 & 1) * 8);
    f16_t* orow = O + (size_t)(R0 + fr) * DM + h * XHD + 4 * g;
    for (int dc = 0; dc < 8; ++dc) {
        if (dc < 7) AT_LOAD(dc + 9);
        const LAS unsigned char* bp = lds + (dc & 1) * 32768;
#pragma unroll
        for (int dt = 0; dt < 4; ++dt) { f32x4 o = (f32x4){0.f, 0.f, 0.f, 0.f};
#pragma unroll
            for (int ks = 0; ks < 8; ++ks) {
                const fp16x4v t1 = __builtin_amdgcn_ds_read_tr16_b64_v4f16((LAS fp16x4v*)(bp + ks * 4096 + voff[dt]));
                const fp16x4v t2 = __builtin_amdgcn_ds_read_tr16_b64_v4f16((LAS fp16x4v*)(bp + ks * 4096 + 2048 + voff[dt]));
                const u32x2 w1 = __builtin_bit_cast(u32x2, t1), w2 = __builtin_bit_cast(u32x2, t2); const u32x4 w = {w1.x, w1.y, w2.x, w2.y};
                o = __builtin_amdgcn_mfma_f32_16x16x32_f16(__builtin_bit_cast(f16x8, w), Pf[ks], o, 0, 0, 0); }
            u32x2 w; w.x = pk16(o[0] * inv_l, o[1] * inv_l); w.y = pk16(o[2] * inv_l, o[3] * inv_l);
            *(u32x2*)(orow + 64 * dc + 16 * dt) = w; }
        if (dc < 7) AT_WRITE((dc + 1) & 1);
        __syncthreads();
    }
#undef AT_LOAD
#undef AT_WRITE
}

__global__ void __launch_bounds__(512, 2) mk_fwd(Args a) {
    extern __shared__ __attribute__((aligned(16))) unsigned char lds_raw[];
    LAS unsigned char* lds = (LAS unsigned char*)lds_raw;
    volatile LAS unsigned* MISC = (volatile LAS unsigned*)(lds + MISC_OFF);
    const int G = gridDim.x, bx = blockIdx.x;
#define OPAQUE_TID() int tid = threadIdx.x; asm volatile("" : "+v"(tid)); const int lane = tid & 63, wave = __builtin_amdgcn_readfirstlane(tid >> 6); (void)lane; (void)wave
    const int vcu = (G % 8 == 0) ? (bx % 8) * (G / 8) + bx / 8 : bx;
    unsigned char* ws = a.ws;
    if (threadIdx.x < 64) MISC[threadIdx.x] = 0u;
    __syncthreads();
    XcdBarrier bar; bar.bar = (unsigned*)(ws + WS_CTL) + CW_BAR; bar.x = 0; bar.st = nullptr;
    if (!MK_PER_STEP) bar = xcd_barrier_post((unsigned*)(ws + WS_CTL) + CW_BAR, MISC + 8);

    float* H = a.out;
    f16_t* XA = (f16_t*)(ws + WS_XA); f16_t* XB = (f16_t*)(ws + WS_XB); f16_t* ACT = (f16_t*)(ws + WS_ACT);
    float* P1 = (float*)(ws + WS_PART1); float* P2 = (float*)(ws + WS_PART2); float* P3 = (float*)(ws + WS_PART3);

    for (int st = a.lo; st < a.hi; ++st) {
        if (st == ST_PREP) { OPAQUE_TID(); step_prep(a, lds, G, vcu, tid, wave, lane); }
        else if (st == ST_G1 || st == ST_G7) {
            pg8::Gemm g{XA, (const f16_t*)(ws + (st == ST_G1 ? WS_W1IN : WS_W2IN)), TROWS, 2 * DFF, DM}; pg8::StaticOrder S; S.init(TROWS, 2 * DFF, G, bx);
            pg8::EpiSwiGLU E{ACT, st == ST_G1 ? nullptr : P3};
            pg8::gemm_phase(lds, g, S, E);
        } else if (st == ST_G2 || st == ST_G4 || st == ST_G6 || st == ST_G8) {
            const f16_t* A; const f16_t* Bt; int K; const float* base; f16_t* HG; const float* gn; float* part; float alpha;
            if (st == ST_G2)      { A = ACT; Bt = (const f16_t*)(ws + WS_W1OUT);  K = DFF; base = inp(I_X); HG = XB;      gn = inp(I_GMIX);   part = P1;      alpha = 0.5f; }
            else if (st == ST_G4) { A = XA;  Bt = (const f16_t*)(ws + WS_WMIXOUT); K = DM;  base = H;         HG = XB;      gn = inp(I_GXATTN); part = P2;      alpha = 1.0f; }
            else if (st == ST_G6) { A = XB;  Bt = (const f16_t*)(ws + WS_WO);      K = DM;  base = H;         HG = XA;      gn = inp(I_GFFN2);  part = P3;      alpha = 1.0f; }
            else                  { A = ACT; Bt = (const f16_t*)(ws + WS_W2OUT);  K = DFF; base = H;         HG = nullptr; gn = nullptr;        part = nullptr; alpha = 0.5f; }
            pg8::Gemm g{A, Bt, TROWS, DM, K}; pg8::StaticOrder S; S.init(TROWS, DM, G, bx);
            pg8::EpiRes E{base, H, HG, gn, part, alpha};
            pg8::gemm_phase(lds, g, S, E);
        } else if (st == ST_G3 || st == ST_G5 || st == ST_KV) {
            const f16_t* A; const f16_t* Bt; int M, N, ldc, c; f16_t* O; const float* part; float scale;
            if (st == ST_G3)      { A = XB; Bt = (const f16_t*)(ws + WS_WMIXIN); M = TROWS; N = INC;    O = ACT; ldc = INC;    part = P1; scale = 1.0f; c = bx; }
            else if (st == ST_G5) { A = XB; Bt = (const f16_t*)(ws + WS_WQ);     M = TROWS; N = DM;     O = XA;  ldc = DM;     part = P2; scale = 0.04419417382f * 1.44269504089f; c = bx; }
            else                  { A = (const f16_t*)(ws + WS_MEMN); Bt = (const f16_t*)(ws + WS_WKV); M = MROWS; N = 2 * DM; O = (f16_t*)(ws + WS_KV); ldc = 2 * DM; part = nullptr; scale = 1.0f; c = (bx + G / 2) % G; }
            pg8::Gemm g{A, Bt, M, N, DM}; pg8::StaticOrder S; S.init(M, N, G, c);
            pg8::EpiF16 E{O, ldc, part, scale};
            pg8::gemm_phase(lds, g, S, E);
        } else if (st == ST_MIX) {
            OPAQUE_TID();
            for (int u = vcu; u < TROWS / 32; u += G) conv_unit(a, u, tid);
            for (int u = vcu; u < (TROWS / 128) * 8; u += G) gm_unit(a, lds, u, tid, wave, lane);
        } else if (st == ST_ATT) {
            OPAQUE_TID();
            for (int u = bx; u < NB * XH * (SEQ / 128); u += G) { const int pair = u & 7, qb = u >> 3; attn_unit(a, lds, pair >> 2, pair & 3, qb, tid, wave, lane); }
        } else if (st == ST_FIN) {
            OPAQUE_TID();
            const int gw = vcu * 8 + wave, NGW = G * 8;
            for (int m = gw; m < TROWS; m += NGW) {
                f32x4* xr = (f32x4*)(H + (size_t)m * DM) + lane; const f32x4* gr = (const f32x4*)inp(I_GFINAL) + lane;
                f32x4 v[8]; float s = 0.f;
#pragma unroll
                for (int j = 0; j < 8; ++j) { v[j] = xr[64 * j]; s += (v[j][0] * v[j][0] + v[j][1] * v[j][1]) + (v[j][2] * v[j][2] + v[j][3] * v[j][3]); }
                const float rs = __builtin_amdgcn_rsqf(wave_sum(s) * (1.f / DM) + EPS);
#pragma unroll
                for (int j = 0; j < 8; ++j) xr[64 * j] = v[j] * rs * gr[64 * j];
            }
        }
        if (!MK_PER_STEP && st + 1 < a.hi && st != ST_G3) xcd_barrier(bar);
    }
}


#ifndef MK_DEBUG
#define MK_DEBUG 0
#endif
#if MK_DEBUG
constexpr size_t WS_HOLD = 356 * MiB;
__device__ __forceinline__ unsigned hash32(unsigned x) { x ^= x >> 16; x *= 0x7feb352du; x ^= x >> 15; x *= 0x846ca68bu; x ^= x >> 16; return x; }
__device__ __forceinline__ float r16(float v) { return (float)(_Float16)v; }
__device__ __forceinline__ bool bad(float got, float ref) { return !(fabsf(got - ref) <= 0.02f * fabsf(ref) + 0.02f); }
__device__ __forceinline__ float rs_of_row(const float* H, int r) { float s = 0.f; for (int c = 0; c < DM; ++c) s += H[(size_t)r * DM + c] * H[(size_t)r * DM + c]; return 1.0f / sqrtf(s / DM + EPS); }
__global__ void chk_step(Args a, int st, unsigned* flags) {
    const unsigned char* ws = a.ws; const unsigned sid = blockIdx.x * blockDim.x + threadIdx.x; const unsigned h1 = hash32(sid * 2654435761u + 12345u + st * 977u), h2 = hash32(h1 + 0x9e3779b9u);
    const float* H = a.out; const float* HOLD = (const float*)(ws + WS_HOLD);
    const f16_t* XA = (const f16_t*)(ws + WS_XA); const f16_t* XB = (const f16_t*)(ws + WS_XB); const f16_t* ACT = (const f16_t*)(ws + WS_ACT);
    bool f = false;
    if (st == ST_PREP) {
        const int which = sid % 13;
        if (which < 10) {
            int ii, K, N; size_t off;
            switch (which) { case 0: ii = I_W1IN; K = DM; N = 2 * DFF; off = WS_W1IN; break; case 1: ii = I_W1OUT; K = DFF; N = DM; off = WS_W1OUT; break; case 2: ii = I_WMIXIN; K = DM; N = INC; off = WS_WMIXIN; break;
                case 3: ii = I_WMIXOUT; K = DM; N = DM; off = WS_WMIXOUT; break; case 4: ii = I_WQ; K = DM; N = DM; off = WS_WQ; break; case 5: ii = I_WK; K = DM; N = DM; off = WS_WKV; break;
                case 6: ii = I_WV; K = DM; N = DM; off = WS_WKV; break; case 7: ii = I_WO; K = DM; N = DM; off = WS_WO; break; case 8: ii = I_W2IN; K = DM; N = 2 * DFF; off = WS_W2IN; break; default: ii = I_W2OUT; K = DFF; N = DM; off = WS_W2OUT; break; }
            const float* Wsrc = a.in[0]; for (int q = 0; q < 23; ++q) if (q == ii) Wsrc = a.in[q];
            const int k = h1 % K, n = h2 % N; int row = n;
            if (which == 0 || which == 8) { const int up = n >= DFF, nn = n - up * DFF; row = (nn >> 7) * 256 + up * 128 + (nn & 127); }
            if (which == 6) row = n + DM;
            const float ref = r16(Wsrc[(size_t)k * N + n]), got = (float)((const f16_t*)(ws + off))[(size_t)row * K + k];
            f = !(fabsf(got - ref) <= 1e-6f);
        } else if (which == 10) { const int r = h1 % TROWS, c = h2 % DM; float s = 0.f; for (int j = 0; j < DM; ++j) { const float v = a.in[I_X][(size_t)r * DM + j]; s += v * v; }
            f = bad((float)XA[(size_t)r * DM + c], a.in[I_X][(size_t)r * DM + c] / sqrtf(s / DM + EPS) * a.in[I_GFFN1][c]);
        } else if (which == 11) { const int r = h1 % MROWS, c = h2 % DM; float s = 0.f; for (int j = 0; j < DM; ++j) { const float v = a.in[I_MEM][(size_t)r * DM + j]; s += v * v; }
            f = bad((float)((const f16_t*)(ws + WS_MEMN))[(size_t)r * DM + c], a.in[I_MEM][(size_t)r * DM + c] / sqrtf(s / DM + EPS) * a.in[I_GMEM][c]);
        } else { const int i = h1 % (8 * 128 * 128), t = (i >> 7) & 127, s = i & 127; f = bad((float)((const f16_t*)(ws + WS_WSP))[i], s <= t ? a.in[I_WSP][i] : 0.f); }
    } else if (st == ST_G1 || st == ST_G7) {
        const int r = h1 % TROWS, j = h2 % DFF; const float* W = a.in[st == ST_G1 ? I_W1IN : I_W2IN]; float g = 0.f, u = 0.f;
        for (int k = 0; k < DM; ++k) { const float x = (float)XA[(size_t)r * DM + k]; g += x * r16(W[(size_t)k * (2 * DFF) + j]); u += x * r16(W[(size_t)k * (2 * DFF) + DFF + j]); }
        if (st == ST_G7) { const float rs = rs_of_row(H, r); g *= rs; u *= rs; }
        f = bad((float)ACT[(size_t)r * DFF + j], g / (1.f + expf(-g)) * u);
    } else if (st == ST_G2 || st == ST_G4 || st == ST_G6 || st == ST_G8) {
        const int r = h1 % TROWS, c = h2 % DM; const f16_t* A; int K; const float* W; const float* base; const f16_t* HG; const float* gn; const float* part; float alpha;
        if (st == ST_G2)      { A = ACT; K = DFF; W = a.in[I_W1OUT];  base = a.in[I_X]; HG = XB; gn = a.in[I_GMIX];   part = (const float*)(ws + WS_PART1); alpha = 0.5f; }
        else if (st == ST_G4) { A = XA;  K = DM;  W = a.in[I_WMIXOUT]; base = HOLD;      HG = XB; gn = a.in[I_GXATTN]; part = (const float*)(ws + WS_PART2); alpha = 1.f; }
        else if (st == ST_G6) { A = XB;  K = DM;  W = a.in[I_WO];      base = HOLD;      HG = XA; gn = a.in[I_GFFN2];  part = (const float*)(ws + WS_PART3); alpha = 1.f; }
        else                  { A = ACT; K = DFF; W = a.in[I_W2OUT];  base = HOLD;      HG = nullptr; gn = nullptr; part = nullptr; alpha = 0.5f; }
        float s = 0.f; for (int k = 0; k < K; ++k) s += (float)A[(size_t)r * K + k] * r16(W[(size_t)k * DM + c]);
        const float ref = base[(size_t)r * DM + c] + alpha * s; f = bad(H[(size_t)r * DM + c], ref);
        if (HG) f = f || bad((float)HG[(size_t)r * DM + c], H[(size_t)r * DM + c] * gn[c]);
        if (part) { float ps = 0.f; for (int j = 0; j < NPART; ++j) ps += part[(size_t)r * NPART + j]; float hs = 0.f; for (int j = 0; j < DM; ++j) hs += H[(size_t)r * DM + j] * H[(size_t)r * DM + j]; f = f || bad(ps, hs); }
    } else if (st == ST_G3 || st == ST_G5) {
        const int N = st == ST_G3 ? INC : DM; const int r = h1 % TROWS, n = h2 % N; const float* W = a.in[st == ST_G3 ? I_WMIXIN : I_WQ]; const f16_t* O = st == ST_G3 ? ACT : XA;
        float s = 0.f; for (int k = 0; k < DM; ++k) s += (float)XB[(size_t)r * DM + k] * r16(W[(size_t)k * N + n]);
        s *= rs_of_row(H, r); if (st == ST_G5) s *= 0.04419417382f * 1.44269504089f;
        f = bad((float)O[(size_t)r * N + n], s);
    } else if (st == ST_KV) {
        const int r = h1 % MROWS, n = h2 % (2 * DM); const float* W = a.in[n < DM ? I_WK : I_WV]; const int nn = n % DM; const f16_t* MN = (const f16_t*)(ws + WS_MEMN);
        float s = 0.f; for (int k = 0; k < DM; ++k) s += (float)MN[(size_t)r * DM + k] * r16(W[(size_t)k * DM + nn]);
        f = bad((float)((const f16_t*)(ws + WS_KV))[(size_t)r * 2 * DM + n], s);
    } else if (st == ST_MIX) {
        const int r = h1 % TROWS, c = h2 % DM, t = r & (SEQ - 1); const f16_t* Z = ACT; float ref;
        if (c < CW) { float acc = a.in[I_CONVB][c];
            for (int k = 0; k < 3; ++k) { const int tt = t - 2 + k; if (tt >= 0) { const size_t rr = (size_t)(r - 2 + k) * INC; acc += a.in[I_CONVW][k * CW + c] * (float)Z[rr + CW + c] * (float)Z[rr + 2 * CW + c]; } }
            ref = (float)Z[(size_t)r * INC + c] * acc;
        } else { const int cc = c - CW, head = cc >> 7, R0 = r & ~127, tq = r & 127; float sg = a.in[I_BSP][head * 128 + tq];
            for (int s = 0; s <= tq; ++s) { float ss = 0.f; for (int j = 0; j < 128; ++j) { const float v = (float)Z[(size_t)(R0 + s) * INC + 4 * CW + head * 128 + j]; ss += v * v; }
                const float vn = (float)Z[(size_t)(R0 + s) * INC + 4 * CW + cc] / sqrtf(ss / 128.f + EPS) * a.in[I_GGMV][cc]; sg += a.in[I_WSP][(size_t)head * 128 * 128 + tq * 128 + s] * vn; }
            ref = (float)Z[(size_t)r * INC + 3 * CW + cc] * sg; }
        f = bad((float)XA[(size_t)r * DM + c], ref);
    } else if (st == ST_ATT) {
        const int r = h1 % TROWS, c = h2 % DM, hh = c / XHD, b = r / SEQ; const f16_t* KV = (const f16_t*)(ws + WS_KV);
        float mx = -1e30f;
        for (int m = 0; m < NMEM; ++m) { float s = 0.f; for (int d = 0; d < XHD; ++d) s += (float)XA[(size_t)r * DM + hh * XHD + d] * (float)KV[(size_t)(b * NMEM + m) * 2 * DM + hh * XHD + d]; mx = fmaxf(mx, s); }
        float l = 0.f, o = 0.f;
        for (int m = 0; m < NMEM; ++m) { float s = 0.f; for (int d = 0; d < XHD; ++d) s += (float)XA[(size_t)r * DM + hh * XHD + d] * (float)KV[(size_t)(b * NMEM + m) * 2 * DM + hh * XHD + d];
            const float p = exp2f(s - mx); l += p; o += p * (float)KV[(size_t)(b * NMEM + m) * 2 * DM + DM + c]; }
        f = bad((float)XB[(size_t)r * DM + c], o / l);
    } else if (st == ST_FIN) {
        const int r = h1 % TROWS, c = h2 % DM; f = bad(H[(size_t)r * DM + c], HOLD[(size_t)r * DM + c] * rs_of_row(HOLD, r) * a.in[I_GFINAL][c]);
    }
    if (f) atomicOr(flags, 1u << st);
}
__global__ void chk_final(float* out, const unsigned* flags) {
    const size_t i = (size_t)blockIdx.x * blockDim.x + threadIdx.x;
    if (i < (size_t)TROWS * DM) out[i] = 0.f;
    if (i == 0) { const unsigned fl = *flags; int code = 0; for (int s = ST_N - 1; s >= 0; --s) if ((fl >> s) & 1u) code = s + 1; out[0] = (10.f + code) * 100.f; }
}
#endif

extern "C" void kernel_launch(void* const* d_in, const int* in_sizes, int n_in, void* d_out, int out_size, void* d_ws, size_t ws_size, hipStream_t stream) {
    static int grid = 0;
    if (grid == 0) {
        if (n_in != 23 || in_sizes[0] != TROWS * DM || out_size != TROWS * DM || ws_size < WS_END + (MK_DEBUG ? 64 * MiB : 0)) {
            fprintf(stderr, "kernel_launch: built for 23 inputs, x/out of %d floats, >= %zu bytes of workspace; got n_in %d, in0 %d, out %d, ws %zu; nothing launched\n", TROWS * DM, (size_t)WS_END, n_in, n_in > 0 ? in_sizes[0] : -1, out_size, ws_size); grid = -1; return; }
        int dev = 0, cus = 0, per_cu = 0;
        if (hipGetDevice(&dev) != hipSuccess || hipDeviceGetAttribute(&cus, hipDeviceAttributeMultiprocessorCount, dev) != hipSuccess) { fprintf(stderr, "kernel_launch: device query failed\n"); grid = -1; return; }
        if (hipFuncSetAttribute((const void*)mk_fwd, hipFuncAttributeMaxDynamicSharedMemorySize, LDS_BYTES) != hipSuccess) { fprintf(stderr, "kernel_launch: hipFuncSetAttribute failed\n"); grid = -1; return; }
        if (hipOccupancyMaxActiveBlocksPerMultiprocessor(&per_cu, (const void*)mk_fwd, 512, LDS_BYTES) != hipSuccess || per_cu < 1) { fprintf(stderr, "kernel_launch: occupancy query reports %d blocks per CU; nothing launched\n", per_cu); (void)hipGetLastError(); grid = -1; return; }
        grid = cus;
    }
    if (grid < 0) return;
    if (hipMemsetAsync((char*)d_ws + WS_CTL, 0, CTL_ZERO_BYTES, stream) != hipSuccess) { fprintf(stderr, "kernel_launch: memset failed\n"); return; }
    Args a{};
    for (int i = 0; i < 23; ++i) a.in[i] = (const float*)d_in[i];
    a.out = (float*)d_out; a.ws = (unsigned char*)d_ws;
#if MK_PER_STEP
    for (int s = 0; s < ST_N; ++s) { a.lo = s; a.hi = s + 1;
#if MK_DEBUG
        if (s == ST_G4 || s == ST_G6 || s == ST_G8 || s == ST_FIN) (void)hipMemcpyAsync((char*)d_ws + WS_HOLD, d_out, (size_t)TROWS * DM * 4, hipMemcpyDeviceToDevice, stream);
#endif
        hipLaunchKernelGGL(mk_fwd, dim3(grid), dim3(512), LDS_BYTES, stream, a);
#if MK_DEBUG
        hipLaunchKernelGGL(chk_step, dim3(16), dim3(256), 0, stream, a, s, (unsigned*)d_ws + 64);
#endif
    }
#if MK_DEBUG
    hipLaunchKernelGGL(chk_final, dim3(TROWS * DM / 256), dim3(256), 0, stream, (float*)d_out, (const unsigned*)d_ws + 64);
#endif
#else
    a.lo = 0; a.hi = ST_N;
    hipLaunchKernelGGL(mk_fwd, dim3(grid), dim3(512), LDS_BYTES, stream, a);
#endif
    const hipError_t le = hipPeekAtLastError();
    if (le != hipSuccess) fprintf(stderr, "kernel_launch: launch failed: %s\n", hipGetErrorName(le));
}
```

```cpp
#include <hip/hip_runtime.h>
#include <cstdio>
#include <cstdint>

#ifndef MK_REP_MASK
#define MK_REP_MASK 0
#endif
#ifndef MK_BAR_REP
#define MK_BAR_REP 1
#endif
#ifndef MK_PER_STEP
#define MK_PER_STEP 0
#endif

#define LAS __attribute__((address_space(3)))
typedef _Float16 f16_t;
typedef _Float16 f16x8 __attribute__((ext_vector_type(8)));
typedef _Float16 f16x2 __attribute__((ext_vector_type(2)));
typedef __fp16 fp16x4v __attribute__((__vector_size__(4 * sizeof(__fp16))));
typedef float f32x4 __attribute__((ext_vector_type(4)));
typedef unsigned u32x4 __attribute__((ext_vector_type(4)));
typedef unsigned u32x2 __attribute__((ext_vector_type(2)));

constexpr int NB = 2, SEQ = 4096, DM = 2048, TROWS = NB * SEQ;
constexpr int DFF = 5632, INC = 5120, CW = 1024, GMW = 1024, NMEM = 256, MROWS = NB * NMEM;
constexpr int XH = 4, XHD = 512;
constexpr float EPS = 1e-6f;
constexpr int NPART = 32;

__device__ __forceinline__ unsigned pk16(float a, float b) { f16x2 v = {(_Float16)a, (_Float16)b}; return __builtin_bit_cast(unsigned, v); }
__device__ __forceinline__ f16x2 as_h2(unsigned u) { const unsigned t = u; return __builtin_bit_cast(f16x2, t); }

namespace pg8 {
constexpr int BM = 256, BK = 64, HALF = 128, HTB = HALF * BK * 2  , STAGE_BYTES = 8 * HTB, NXCD = 8, WGM = 8;
__host__ __device__ __forceinline__ int lds_byte(int r, int c) { const int st = (r >> 4) * 2 + (c >> 5), rr = r & 15, cc = c & 31, ob = rr * 64 + cc * 2; return st * 1024 + (ob ^ (((ob >> 9) & 1) << 5)); }
__host__ __device__ __forceinline__ void stage_rc(int b, int& R, int& C) { const int st = b / 1024, sb = b % 1024, swz = sb ^ (((sb >> 9) & 1) << 5); R = (st >> 1) * 16 + swz / 64; C = (st & 1) * 32 + (swz % 64) / 2; }
__host__ __device__ __forceinline__ int perm32(int rho) { const int n = rho >> 4, i = rho & 15; return 8 * (i >> 2) + 4 * n + (i & 3); }

struct Unit { int pm, pn; };
struct Gemm { const f16_t* A; const f16_t* Bt; int M, N, K; };

struct StaticOrder {
    int nM, nN, nwg, G, c;
    __device__ void init(int M, int N, int G_, int c_) { nM = M / BM; nN = N / BM; nwg = nM * nN; G = G_; c = c_; }
    __device__ bool next(int i, Unit& u) const {
        const long L = (long)i * G + c; if (L >= nwg) return false;
        int wgid = (int)L; { const int q = nwg / NXCD, r = nwg % NXCD, xcd = wgid % NXCD, off = wgid / NXCD; wgid = (xcd < r ? xcd * (q + 1) : r * (q + 1) + (xcd - r) * q) + off; }
        const int nig = WGM * nN, gid = wgid / nig, fm = gid * WGM, gsz = (nM - fm) < WGM ? (nM - fm) : WGM;
        u.pm = fm + ((wgid % nig) % gsz); u.pn = (wgid % nig) / gsz; return true;
    }
};

__device__ __forceinline__ void row_rs(const float* part, int pm, int wr, int lane, float (&rsv)[2]) {
#pragma unroll
    for (int ai = 0; ai < 2; ++ai) {
        const f32x4* p = (const f32x4*)(part + (size_t)(pm * BM + ai * HALF + wr * 64 + lane) * NPART);
        f32x4 s = p[0];
#pragma unroll
        for (int j = 1; j < NPART / 4; ++j) s += p[j];
        rsv[ai] = __builtin_amdgcn_rsqf(((s[0] + s[1]) + (s[2] + s[3])) * (1.0f / DM) + EPS);
    }
}

struct EpiF16 {
    f16_t* O; int ldc; const float* part; float scale;
    __device__ __forceinline__ void operator()(const f32x4 (&acc)[2][2][4][2], const Unit& u, int wr, int wc, int fr, int fq) const {
        const int lane = fq * 16 + fr; float rsv[2] = {1.f, 1.f};
        if (part) row_rs(part, u.pm, wr, lane, rsv);
        const int row0 = u.pm * BM + wr * 64 + fr, col0 = u.pn * BM + wc * 32 + 8 * fq;
#pragma unroll
        for (int ai = 0; ai < 2; ++ai)
#pragma unroll
            for (int m = 0; m < 4; ++m) {
                float s = scale; if (part) s *= __shfl(rsv[ai], m * 16 + fr);
                f16_t* rowp = O + (size_t)(row0 + ai * HALF + m * 16) * ldc + col0;
#pragma unroll
                for (int bj = 0; bj < 2; ++bj) { const f32x4 v0 = acc[ai][bj][m][0] * s, v1 = acc[ai][bj][m][1] * s;
                    u32x4 w; w.x = pk16(v0[0], v0[1]); w.y = pk16(v0[2], v0[3]); w.z = pk16(v1[0], v1[1]); w.w = pk16(v1[2], v1[3]);
                    *(u32x4*)(rowp + bj * HALF) = w; } }
    }
};
struct EpiSwiGLU {
    f16_t* O; const float* part;
    __device__ __forceinline__ void operator()(const f32x4 (&acc)[2][2][4][2], const Unit& u, int wr, int wc, int fr, int fq) const {
        const int lane = fq * 16 + fr; float rsv[2] = {1.f, 1.f};
        if (part) row_rs(part, u.pm, wr, lane, rsv);
        const int row0 = u.pm * BM + wr * 64 + fr, col0 = u.pn * HALF + wc * 32 + 8 * fq;
#pragma unroll
        for (int ai = 0; ai < 2; ++ai)
#pragma unroll
            for (int m = 0; m < 4; ++m) {
                float s = 1.f; if (part) s = __shfl(rsv[ai], m * 16 + fr);
                float o[8];
#pragma unroll
                for (int n = 0; n < 2; ++n)
#pragma unroll
                    for (int j = 0; j < 4; ++j) { const float g = acc[ai][0][m][n][j] * s, up = acc[ai][1][m][n][j] * s;
                        const float e = __builtin_amdgcn_exp2f(g * -1.44269504089f); o[n * 4 + j] = g * __builtin_amdgcn_rcpf(1.0f + e) * up; }
                u32x4 w; w.x = pk16(o[0], o[1]); w.y = pk16(o[2], o[3]); w.z = pk16(o[4], o[5]); w.w = pk16(o[6], o[7]);
                *(u32x4*)(O + (size_t)(row0 + ai * HALF + m * 16) * DFF + col0) = w; }
    }
};
struct EpiRes {
    const float* base; float* H; f16_t* HG; const float* g; float* part; float alpha;
    __device__ __forceinline__ void operator()(const f32x4 (&acc)[2][2][4][2], const Unit& u, int wr, int wc, int fr, int fq) const {
        const int row0 = u.pm * BM + wr * 64 + fr, col0 = u.pn * BM + wc * 32 + 8 * fq;
        f32x4 gv[2][2];
#pragma unroll
        for (int bj = 0; bj < 2; ++bj)
#pragma unroll
            for (int n = 0; n < 2; ++n) gv[bj][n] = HG ? *(const f32x4*)(g + col0 + bj * HALF + 4 * n) : (f32x4){0.f, 0.f, 0.f, 0.f};
#pragma unroll
        for (int ai = 0; ai < 2; ++ai)
#pragma unroll
            for (int m = 0; m < 4; ++m) {
                const int row = row0 + ai * HALF + m * 16; const size_t off = (size_t)row * DM + col0; float ss = 0.f;
#pragma unroll
                for (int bj = 0; bj < 2; ++bj) {
                    const f32x4 b0 = *(const f32x4*)(base + off + bj * HALF), b1 = *(const f32x4*)(base + off + bj * HALF + 4);
                    const f32x4 h0 = b0 + acc[ai][bj][m][0] * alpha, h1 = b1 + acc[ai][bj][m][1] * alpha;
                    *(f32x4*)(H + off + bj * HALF) = h0; *(f32x4*)(H + off + bj * HALF + 4) = h1;
                    ss += (h0[0] * h0[0] + h0[1] * h0[1]) + (h0[2] * h0[2] + h0[3] * h0[3]) + (h1[0] * h1[0] + h1[1] * h1[1]) + (h1[2] * h1[2] + h1[3] * h1[3]);
                    if (HG) { const f32x4 a = h0 * gv[bj][0], b = h1 * gv[bj][1];
                        u32x4 w; w.x = pk16(a[0], a[1]); w.y = pk16(a[2], a[3]); w.z = pk16(b[0], b[1]); w.w = pk16(b[2], b[3]);
                        *(u32x4*)(HG + off + bj * HALF) = w; } }
                ss += __shfl_xor(ss, 16); ss += __shfl_xor(ss, 32);
                if (part && fq == 0) part[(size_t)row * NPART + u.pn * 4 + wc] = ss;
                if (m & 1) asm volatile("" ::: "memory"); }
    }
};

template <class Epi>
__device__ __forceinline__ void gemm_phase(LAS unsigned char* lds, const Gemm g, const StaticOrder& S, const Epi& E) {
    int tid_ = threadIdx.x; asm volatile("" : "+v"(tid_));
    const int tid = tid_, wid = __builtin_amdgcn_readfirstlane(tid >> 6), lane = tid & 63, wr = wid >> 2, wc = wid & 3, fr = lane & 15, fq = lane >> 4;
    const int K = g.K, nt = K / BK;
    unsigned voffA[2], voffB[2];
#pragma unroll
    for (int i = 0; i < 2; ++i) { int R, C; stage_rc(tid * 16 + i * 8192, R, C); const int Rb = (R & ~31) + perm32(R & 31);
        voffA[i] = (unsigned)(R * K + C) * 2u; voffB[i] = (unsigned)(Rb * K + C) * 2u; }
    const size_t kstep = (size_t)(BK * 2);
    const size_t hstep = (size_t)HALF * K * 2;
    const size_t tstep = 2 * hstep;
    const unsigned ldsw = (unsigned)wid * 1024u;
    const int aoff = lds_byte(wr * 64 + fr, fq * 8), boff = lds_byte(wc * 32 + fr, fq * 8);
#define PG8_SA(b, h) (((b) * 2 + (h)) * HTB)
#define PG8_SB(b, h) ((4 + (b) * 2 + (h)) * HTB)
#define PG8_STAGE(bufoff, gbase, voff) do { _Pragma("unroll") for (int _i = 0; _i < 2; ++_i) \
        __builtin_amdgcn_global_load_lds((const unsigned*)((const char*)(gbase) + (voff)[_i]), (LAS unsigned*)(lds + (bufoff) + ldsw + _i * 8192), 16, 0, 0); } while (0)
#define PG8_LDA(dst, b, h) do { _Pragma("unroll") for (int m = 0; m < 4; ++m) _Pragma("unroll") for (int k = 0; k < 2; ++k) dst[m][k] = *(const LAS f16x8*)(lds + PG8_SA(b, h) + aoff + m * 2048 + k * 1024); } while (0)
#define PG8_LDB(dst, b, h) do { _Pragma("unroll") for (int n = 0; n < 2; ++n) _Pragma("unroll") for (int k = 0; k < 2; ++k) dst[n][k] = *(const LAS f16x8*)(lds + PG8_SB(b, h) + boff + n * 2048 + k * 1024); } while (0)
#define PG8_MMA(ai, bj, At, Bt) do { __builtin_amdgcn_s_setprio(1); _Pragma("unroll") for (int m = 0; m < 4; ++m) _Pragma("unroll") for (int n = 0; n < 2; ++n) _Pragma("unroll") for (int k = 0; k < 2; ++k) \
        acc[ai][bj][m][n] = __builtin_amdgcn_mfma_f32_16x16x32_f16(Bt[n][k], At[m][k], acc[ai][bj][m][n], 0, 0, 0); __builtin_amdgcn_s_setprio(0); } while (0)
#define PG8_WAIT_V(n) asm volatile("s_waitcnt vmcnt(" #n ")" ::: "memory")
#define PG8_WAIT_L(n) asm volatile("s_waitcnt lgkmcnt(" #n ")" ::: "memory")
#define PG8_BAR __builtin_amdgcn_s_barrier()
#define PG8_SCHED __builtin_amdgcn_sched_barrier(0)
    Unit cur, nxt; int ui = 0;
    if (!S.next(0, cur)) return;
    f32x4 acc[2][2][4][2];
#pragma unroll
    for (int a = 0; a < 2; ++a)
#pragma unroll
        for (int b = 0; b < 2; ++b)
#pragma unroll
            for (int m = 0; m < 4; ++m)
#pragma unroll
                for (int n = 0; n < 2; ++n) acc[a][b][m][n] = (f32x4){0.f, 0.f, 0.f, 0.f};
    f16x8 At[4][2], B0[2][2], B1[2][2];
    const char* cA = (const char*)g.A + (size_t)cur.pm * tstep; const char* cB = (const char*)g.Bt + (size_t)cur.pn * tstep;
    PG8_STAGE(PG8_SB(0, 0), cB, voffB); PG8_STAGE(PG8_SB(0, 1), cB + hstep, voffB); PG8_STAGE(PG8_SA(0, 0), cA, voffA); PG8_STAGE(PG8_SA(0, 1), cA + hstep, voffA);
    if (wr == 1) PG8_BAR;
    PG8_WAIT_V(2); PG8_BAR;
    PG8_STAGE(PG8_SB(1, 0), cB + kstep, voffB); PG8_STAGE(PG8_SA(1, 0), cA + kstep, voffA); PG8_STAGE(PG8_SB(1, 1), cB + hstep + kstep, voffB);
    PG8_WAIT_V(6); PG8_BAR;
    for (;;) {
        const bool has_next = S.next(ui + 1, nxt);
        const char* nA = has_next ? (const char*)g.A + (size_t)nxt.pm * tstep : cA; const char* nB = has_next ? (const char*)g.Bt + (size_t)nxt.pn * tstep : cB;
        for (int t = 0; t < nt; t += 2) {
            const bool last = (t == nt - 2);
            const char* a1 = cA + (size_t)(t + 1) * kstep;
            const char* a2 = last ? nA : cA + (size_t)(t + 2) * kstep; const char* b2 = last ? nB : cB + (size_t)(t + 2) * kstep;
            const char* a3 = a2 + kstep; const char* b3 = b2 + kstep;
            PG8_LDB(B0, 0, 0); PG8_LDB(B1, 0, 1); PG8_SCHED; PG8_LDA(At, 0, 0); PG8_STAGE(PG8_SA(1, 1), a1 + hstep, voffA);
            PG8_WAIT_V(8); PG8_WAIT_L(0); PG8_BAR; PG8_MMA(0, 0, At, B0); PG8_MMA(0, 1, At, B1); PG8_BAR; PG8_SCHED;
            PG8_LDA(At, 0, 1); PG8_STAGE(PG8_SB(0, 0), b2, voffB); PG8_STAGE(PG8_SB(0, 1), b2 + hstep, voffB); PG8_STAGE(PG8_SA(0, 0), a2, voffA);
            PG8_WAIT_V(8); PG8_WAIT_L(0); PG8_BAR; PG8_MMA(1, 0, At, B0); PG8_MMA(1, 1, At, B1); PG8_BAR; PG8_SCHED;
            PG8_LDB(B0, 1, 0); PG8_LDB(B1, 1, 1); PG8_SCHED; PG8_LDA(At, 1, 0); PG8_STAGE(PG8_SA(0, 1), a2 + hstep, voffA);
            PG8_WAIT_V(8); PG8_WAIT_L(0); PG8_BAR; PG8_MMA(0, 0, At, B0); PG8_MMA(0, 1, At, B1); PG8_BAR; PG8_SCHED;
            PG8_LDA(At, 1, 1); PG8_STAGE(PG8_SB(1, 0), b3, voffB); PG8_STAGE(PG8_SB(1, 1), b3 + hstep, voffB); PG8_STAGE(PG8_SA(1, 0), a3, voffA);
            PG8_WAIT_V(8); PG8_WAIT_L(0); PG8_BAR; PG8_MMA(1, 0, At, B0); PG8_MMA(1, 1, At, B1); PG8_BAR; PG8_SCHED;
        }
        if (wr == 0) PG8_BAR;
        E(acc, cur, wr, wc, fr, fq);
        if (!has_next) break;
#pragma unroll
        for (int a = 0; a < 2; ++a)
#pragma unroll
            for (int b = 0; b < 2; ++b)
#pragma unroll
                for (int m = 0; m < 4; ++m)
#pragma unroll
                    for (int n = 0; n < 2; ++n) acc[a][b][m][n] = (f32x4){0.f, 0.f, 0.f, 0.f};
        cur = nxt; cA = nA; cB = nB; ++ui;
        if (wr == 1) PG8_BAR;
    }
    PG8_WAIT_V(0);
    PG8_BAR;
#undef PG8_SA
#undef PG8_SB
#undef PG8_STAGE
#undef PG8_LDA
#undef PG8_LDB
#undef PG8_MMA
#undef PG8_WAIT_V
#undef PG8_WAIT_L
#undef PG8_BAR
#undef PG8_SCHED
}
}

constexpr size_t MiB = 1u << 20;
constexpr size_t WS_CTL = 0, CTL_ZERO_BYTES = 64 * 1024;
constexpr size_t WS_PART1 = 1 * MiB, WS_PART2 = 2 * MiB, WS_PART3 = 3 * MiB;
constexpr size_t WS_WSP = 4 * MiB;
constexpr size_t WS_MEMN = 5 * MiB;
constexpr size_t WS_KV = 7 * MiB;
constexpr size_t WS_W1IN = 12 * MiB, WS_W1OUT = 56 * MiB, WS_WMIXIN = 78 * MiB, WS_WMIXOUT = 98 * MiB, WS_WQ = 106 * MiB, WS_WKV = 114 * MiB,
                 WS_WO = 130 * MiB, WS_W2IN = 138 * MiB, WS_W2OUT = 182 * MiB;
constexpr size_t WS_XA = 204 * MiB, WS_XB = 236 * MiB;
constexpr size_t WS_ACT = 268 * MiB;
constexpr size_t WS_END = 356 * MiB;
constexpr int CW_BAR = 4096;

constexpr int RING_BYTES = 131072;
constexpr int PREP_SCR = 64 * 65 * 4;
constexpr int MISC_OFF = 8 * PREP_SCR;
constexpr int LDS_BYTES = 147456;

#define XB_TMO      128
#define XB_XCNT(j)  (256  + 64 * (j))
#define XB_XSUB(j)  (1280 + 64 * (j))
#define XB_XGEN(j)  (2304 + 64 * (j))
#define XB_TOP      3328
#define XB_TOPGEN   3392
#define XCD_BAR_WORDS 3456
#define XB_SPIN_CAP (1u << 20)
__device__ __forceinline__ unsigned xb_ld(unsigned* p)              { return __hip_atomic_load(p, __ATOMIC_RELAXED, __HIP_MEMORY_SCOPE_AGENT); }
__device__ __forceinline__ unsigned xb_add(unsigned* p, unsigned v) { return __hip_atomic_fetch_add(p, v, __ATOMIC_RELAXED, __HIP_MEMORY_SCOPE_AGENT); }
__device__ __forceinline__ unsigned xb_xcc_id() { return (unsigned)__builtin_amdgcn_s_getreg((3 << 11) | 20) & 0xFu; }
#define XB_SPIN(cond, bar) do { unsigned _sp = 0; while (cond) { __builtin_amdgcn_s_sleep(1); \
    if ((++_sp & 255u) == 0u) { if (xb_ld(&(bar)[XB_TMO])) break; if (_sp > XB_SPIN_CAP) { atomicAdd(&(bar)[XB_TMO], 1u); break; } } } } while (0)
struct XcdBarrier { unsigned* bar; unsigned x; volatile LAS unsigned* st; };
__device__ __forceinline__ XcdBarrier xcd_barrier_post(unsigned* bar, volatile LAS unsigned* st) {
    XcdBarrier b; b.bar = bar; b.x = xb_xcc_id(); b.st = st;
    if (threadIdx.x == 0) (void)xb_add(&bar[XB_XCNT(b.x)], 1u);
    return b;
}
__device__ __forceinline__ void xcd_barrier_complete(unsigned* bar, unsigned x, unsigned& nloc, unsigned& nx) {
    const unsigned G = gridDim.x * gridDim.y * gridDim.z;
    unsigned sum, cnt, mine, sp = 0u;
    for (;;) {
        sum = 0u; cnt = 0u; mine = 0u;
#pragma unroll
        for (unsigned j = 0; j < 16; ++j) { const unsigned c = xb_ld(&bar[XB_XCNT(j)]); sum += c; cnt += (c > 0u) ? 1u : 0u; mine = (j == x) ? c : mine; }
        if (sum == G) break;
        __builtin_amdgcn_s_sleep(1);
        if ((++sp & 255u) == 0u) { if (xb_ld(&bar[XB_TMO])) break; if (sp > XB_SPIN_CAP) { atomicAdd(&bar[XB_TMO], 1u); break; } }
    }
    nloc = mine > 0u ? mine : 1u; nx = cnt > 0u ? cnt : 1u;
}
__device__ __forceinline__ void xcd_barrier(const XcdBarrier& b) {
    asm volatile("s_waitcnt vmcnt(0)" ::: "memory");
    __syncthreads();
    if (threadIdx.x == 0) {
        unsigned* bar = b.bar;
        __builtin_amdgcn_s_waitcnt(0);
        unsigned nloc = b.st[0], nx = b.st[1];
        if (nloc == 0u) { xcd_barrier_complete(bar, b.x, nloc, nx); b.st[0] = nloc; b.st[1] = nx; }
        const unsigned old = xb_add(&bar[XB_XSUB(b.x)], 1u);
        const unsigned gen = old / nloc;
        if (old + 1u == (gen + 1u) * nloc) {
            __builtin_amdgcn_fence(__ATOMIC_RELEASE, "agent");
            asm volatile("s_waitcnt vmcnt(0)" ::: "memory");
            const unsigned og = xb_add(&bar[XB_TOP], 1u);
            const unsigned tg = og / nx;
            if (og + 1u == (tg + 1u) * nx) xb_add(&bar[XB_TOPGEN], 1u);
            else XB_SPIN(xb_ld(&bar[XB_TOPGEN]) == tg, bar);
            __builtin_amdgcn_fence(__ATOMIC_ACQUIRE, "agent");
            xb_add(&bar[XB_XGEN(b.x)], 1u);
            asm volatile("s_waitcnt vmcnt(0)" ::: "memory");
        } else {
            XB_SPIN(xb_ld(&bar[XB_XGEN(b.x)]) == gen, bar);
            __builtin_amdgcn_fence(__ATOMIC_ACQUIRE, "agent");
            asm volatile("s_waitcnt vmcnt(0)" ::: "memory");
        }
    }
    __syncthreads();
}

#define LDS_WAIT() asm volatile("s_waitcnt lgkmcnt(0)" ::: "memory")
__device__ __forceinline__ float wave_sum(float v) {
#pragma unroll
    for (int o = 1; o < 64; o <<= 1) v += __shfl_xor(v, o);
    return v;
}
__device__ __forceinline__ void transpose_item(const float* W, int N, f16_t* WT, int K, int dst_row0, int k0, int n0, LAS float* scr, int lane) {
    const int n4 = lane & 15, kq = lane >> 4;
    const float* src = W + (size_t)(k0 + kq) * N + n0 + 4 * n4;
    f32x4 v[16];
#pragma unroll
    for (int i = 0; i < 16; ++i) v[i] = *(const f32x4*)(src + (size_t)(4 * i) * N);
#pragma unroll
    for (int i = 0; i < 16; ++i) { LAS float* d = scr + (4 * i + kq) * 65 + 4 * n4; d[0] = v[i][0]; d[1] = v[i][1]; d[2] = v[i][2]; d[3] = v[i][3]; }
    LDS_WAIT(); asm volatile("" ::: "memory");
    const int c = lane & 7;
#pragma unroll
    for (int j = 0; j < 8; ++j) { const int n = (lane >> 3) + 8 * j; const LAS float* s = scr + (8 * c) * 65 + n;
        u32x4 o; o.x = pk16(s[0 * 65], s[1 * 65]); o.y = pk16(s[2 * 65], s[3 * 65]); o.z = pk16(s[4 * 65], s[5 * 65]); o.w = pk16(s[6 * 65], s[7 * 65]);
        *(u32x4*)(WT + (size_t)(dst_row0 + n) * K + k0 + 8 * c) = o; }
    LDS_WAIT(); asm volatile("" ::: "memory");
}
__device__ __forceinline__ void prep_mat(const float* W, int K, int N, f16_t* WT, int row_off, bool ileave, int r, LAS float* scr, int lane) {
    const int nblk = N / 64, kb = r / nblk, nb = r - kb * nblk, n0 = 64 * nb;
    int dr;
    if (ileave) { const int half = N / 2, up = n0 >= half ? 1 : 0, nn = n0 - up * half; dr = (nn >> 7) * 256 + up * 128 + (nn & 127); } else dr = row_off + n0;
    transpose_item(W, N, WT, K, dr, 64 * kb, n0, scr, lane);
}
__device__ __forceinline__ void norm_row_f16(const float* xrow, const float* g, f16_t* orow, int lane) {
    const f32x4* xr = (const f32x4*)xrow + lane; const f32x4* gr = (const f32x4*)g + lane;
    f32x4 v[8]; float s = 0.f;
#pragma unroll
    for (int j = 0; j < 8; ++j) { v[j] = xr[64 * j]; s += (v[j][0] * v[j][0] + v[j][1] * v[j][1]) + (v[j][2] * v[j][2] + v[j][3] * v[j][3]); }
    const float rs = __builtin_amdgcn_rsqf(wave_sum(s) * (1.f / DM) + EPS);
    u32x2* o8 = (u32x2*)orow + lane;
#pragma unroll
    for (int j = 0; j < 8; ++j) { const f32x4 gg = gr[64 * j]; u32x2 w; w.x = pk16(v[j][0] * rs * gg[0], v[j][1] * rs * gg[1]); w.y = pk16(v[j][2] * rs * gg[2], v[j][3] * rs * gg[3]); o8[64 * j] = w; }
}

struct Args { const float* in[23]; float* out; unsigned char* ws; int lo, hi; };
__device__ __forceinline__ const float* inp(int i) {
    const __attribute__((address_space(4))) unsigned long long* t = (const __attribute__((address_space(4))) unsigned long long*)__builtin_amdgcn_kernarg_segment_ptr();
    asm volatile("" : "+s"(i));
    return (const float*)t[i];
}
enum { I_X = 0, I_MEM, I_GFFN1, I_W1IN, I_W1OUT, I_GMIX, I_WMIXIN, I_CONVW, I_CONVB, I_GGMV, I_WSP, I_BSP, I_WMIXOUT, I_GXATTN, I_GMEM, I_WQ, I_WK, I_WV, I_WO, I_GFFN2, I_W2IN, I_W2OUT, I_GFINAL };
enum { ST_PREP = 0, ST_G1, ST_G2, ST_G3, ST_KV, ST_MIX, ST_G4, ST_G5, ST_ATT, ST_G6, ST_G7, ST_G8, ST_FIN, ST_N };

__device__ __forceinline__ void step_prep(const Args& a, LAS unsigned char* lds, int G, int vcu, int tid, int wave, int lane) {
    unsigned char* ws = a.ws;
    LAS float* scr = (LAS float*)(lds + wave * PREP_SCR);
    const int gw = vcu * 8 + wave, NGW = G * 8;
    constexpr int I_FIN = (DM / 64) * (2 * DFF / 64), I_FOUT = (DFF / 64) * (DM / 64), I_MIXIN = (DM / 64) * (INC / 64), I_SQ = (DM / 64) * (DM / 64);
    constexpr int NITEMS = 2 * I_FIN + 2 * I_FOUT + I_MIXIN + 5 * I_SQ;
    for (int it = gw; it < NITEMS; it += NGW) {
        int r = it;
        if (r < I_FIN) { prep_mat(inp(I_W1IN), DM, 2 * DFF, (f16_t*)(ws + WS_W1IN), 0, true, r, scr, lane); continue; } r -= I_FIN;
        if (r < I_FOUT) { prep_mat(inp(I_W1OUT), DFF, DM, (f16_t*)(ws + WS_W1OUT), 0, false, r, scr, lane); continue; } r -= I_FOUT;
        if (r < I_MIXIN) { prep_mat(inp(I_WMIXIN), DM, INC, (f16_t*)(ws + WS_WMIXIN), 0, false, r, scr, lane); continue; } r -= I_MIXIN;
        if (r < I_SQ) { prep_mat(inp(I_WMIXOUT), DM, DM, (f16_t*)(ws + WS_WMIXOUT), 0, false, r, scr, lane); continue; } r -= I_SQ;
        if (r < I_SQ) { prep_mat(inp(I_WQ), DM, DM, (f16_t*)(ws + WS_WQ), 0, false, r, scr, lane); continue; } r -= I_SQ;
        if (r < I_SQ) { prep_mat(inp(I_WK), DM, DM, (f16_t*)(ws + WS_WKV), 0, false, r, scr, lane); continue; } r -= I_SQ;
        if (r < I_SQ) { prep_mat(inp(I_WV), DM, DM, (f16_t*)(ws + WS_WKV), DM, false, r, scr, lane); continue; } r -= I_SQ;
        if (r < I_SQ) { prep_mat(inp(I_WO), DM, DM, (f16_t*)(ws + WS_WO), 0, false, r, scr, lane); continue; } r -= I_SQ;
        if (r < I_FIN) { prep_mat(inp(I_W2IN), DM, 2 * DFF, (f16_t*)(ws + WS_W2IN), 0, true, r, scr, lane); continue; } r -= I_FIN;
        prep_mat(inp(I_W2OUT), DFF, DM, (f16_t*)(ws + WS_W2OUT), 0, false, r, scr, lane);
    }
    for (int m = gw; m < TROWS; m += NGW) norm_row_f16(inp(I_X) + (size_t)m * DM, inp(I_GFFN1), (f16_t*)(ws + WS_XA) + (size_t)m * DM, lane);
    for (int m = gw; m < MROWS; m += NGW) norm_row_f16(inp(I_MEM) + (size_t)m * DM, inp(I_GMEM), (f16_t*)(ws + WS_MEMN) + (size_t)m * DM, lane);
    { const f32x4* src = (const f32x4*)inp(I_WSP); u32x2* dst = (u32x2*)(ws + WS_WSP);
      for (int i = vcu * 512 + tid; i < 8 * 128 * 128 / 4; i += G * 512) { const int t = (i >> 5) & 127, s0 = (i & 31) * 4; const f32x4 v = src[i];
          u32x2 w; w.x = pk16(s0 <= t ? v[0] : 0.f, s0 + 1 <= t ? v[1] : 0.f); w.y = pk16(s0 + 2 <= t ? v[2] : 0.f, s0 + 3 <= t ? v[3] : 0.f); dst[i] = w; } }
}

__device__ __forceinline__ void f16x8_to_f32(const u32x4 w, float (&f)[8]) {
#pragma unroll
    for (int j = 0; j < 4; ++j) { const f16x2 h = as_h2(w[j]); f[2 * j] = (float)h[0]; f[2 * j + 1] = (float)h[1]; }
}
__device__ __forceinline__ void conv_unit(const Args& a, int cu, int tid) {
    const f16_t* Z = (const f16_t*)(a.ws + WS_ACT); f16_t* Y = (f16_t*)(a.ws + WS_XA);
    const int cg = tid & 127, rg = tid >> 7, c = 8 * cg, r0 = 32 * cu + 8 * rg;
    float w0[8], w1[8], w2[8], cb[8];
    { const f32x4* p = (const f32x4*)(inp(I_CONVW) + c); const f32x4 a0 = p[0], a1 = p[1], b0 = p[CW / 4], b1 = p[CW / 4 + 1], c0 = p[2 * CW / 4], c1 = p[2 * CW / 4 + 1];
      const f32x4* q = (const f32x4*)(inp(I_CONVB) + c); const f32x4 d0 = q[0], d1 = q[1];
#pragma unroll
      for (int j = 0; j < 4; ++j) { w0[j] = a0[j]; w0[4 + j] = a1[j]; w1[j] = b0[j]; w1[4 + j] = b1[j]; w2[j] = c0[j]; w2[4 + j] = c1[j]; cb[j] = d0[j]; cb[4 + j] = d1[j]; } }
    float m2[8], m1[8];
    const bool first = (r0 & (SEQ - 1)) == 0;
    {
        float x[8], y[8];
        if (!first) {
            f16x8_to_f32(*(const u32x4*)(Z + (size_t)(r0 - 2) * INC + CW + c), x); f16x8_to_f32(*(const u32x4*)(Z + (size_t)(r0 - 2) * INC + 2 * CW + c), y);
#pragma unroll
            for (int j = 0; j < 8; ++j) m2[j] = x[j] * y[j];
            f16x8_to_f32(*(const u32x4*)(Z + (size_t)(r0 - 1) * INC + CW + c), x); f16x8_to_f32(*(const u32x4*)(Z + (size_t)(r0 - 1) * INC + 2 * CW + c), y);
#pragma unroll
            for (int j = 0; j < 8; ++j) m1[j] = x[j] * y[j];
        } else {
#pragma unroll
            for (int j = 0; j < 8; ++j) { m2[j] = 0.f; m1[j] = 0.f; }
        }
    }
#pragma unroll
    for (int rr = 0; rr < 8; ++rr) {
        const size_t ro = (size_t)(r0 + rr) * INC + c;
        float gb[8], gc[8], hc[8], o[8];
        f16x8_to_f32(*(const u32x4*)(Z + ro), gb); f16x8_to_f32(*(const u32x4*)(Z + ro + CW), gc); f16x8_to_f32(*(const u32x4*)(Z + ro + 2 * CW), hc);
#pragma unroll
        for (int j = 0; j < 8; ++j) { const float ch = gc[j] * hc[j]; o[j] = gb[j] * (cb[j] + w2[j] * ch + w1[j] * m1[j] + w0[j] * m2[j]); m2[j] = m1[j]; m1[j] = ch; }
        u32x4 w; w.x = pk16(o[0], o[1]); w.y = pk16(o[2], o[3]); w.z = pk16(o[4], o[5]); w.w = pk16(o[6], o[7]);
        *(u32x4*)(Y + (size_t)(r0 + rr) * DM + c) = w;
    }
}
constexpr int VNT_PITCH = 272;
__device__ __forceinline__ void gm_unit(const Args& a, LAS unsigned char* lds, int gu, int tid, int wave, int lane) {
    const f16_t* Z = (const f16_t*)(a.ws + WS_ACT); f16_t* Y = (f16_t*)(a.ws + WS_XA); const f16_t* WSP = (const f16_t*)(a.ws + WS_WSP);
    const int head = gu & 7, R0 = (gu >> 3) * 128;
    { const int ch = tid & 15, sr = tid >> 4; float gg[8];
      { const f32x4* p = (const f32x4*)(inp(I_GGMV) + head * 128 + 8 * ch); const f32x4 g0 = p[0], g1 = p[1];
#pragma unroll
        for (int j = 0; j < 4; ++j) { gg[j] = g0[j]; gg[4 + j] = g1[j]; } }
#pragma unroll
      for (int ps = 0; ps < 4; ++ps) { const int s = sr + 32 * ps; float v[8];
          f16x8_to_f32(*(const u32x4*)(Z + (size_t)(R0 + s) * INC + 4 * CW + head * 128 + 8 * ch), v);
          float ss = 0.f;
#pragma unroll
          for (int j = 0; j < 8; ++j) ss += v[j] * v[j];
          ss += __shfl_xor(ss, 1); ss += __shfl_xor(ss, 2); ss += __shfl_xor(ss, 4); ss += __shfl_xor(ss, 8);
          const float rs = __builtin_amdgcn_rsqf(ss * (1.f / 128.f) + EPS);
#pragma unroll
          for (int j = 0; j < 8; ++j) *(LAS f16_t*)(lds + (8 * ch + j) * VNT_PITCH + 2 * s) = (f16_t)(v[j] * rs * gg[j]); } }
    __syncthreads();
    const int fr = lane & 15, g = lane >> 4;
    f16x8 Af[4];
#pragma unroll
    for (int ks = 0; ks < 4; ++ks) Af[ks] = *(const LAS f16x8*)(lds + (16 * wave + fr) * VNT_PITCH + (32 * ks + 8 * g) * 2);
    f32x4 acc[8];
    const f16_t* wrow = WSP + (size_t)head * 128 * 128 + (size_t)fr * 128 + 8 * g;
#pragma unroll
    for (int tb = 0; tb < 8; ++tb) { acc[tb] = (f32x4){0.f, 0.f, 0.f, 0.f};
#pragma unroll
        for (int ks = 0; ks < 4; ++ks) if (32 * ks <= 16 * tb + 15) { const f16x8 Bf = *(const f16x8*)(wrow + (size_t)tb * 16 * 128 + 32 * ks);
            acc[tb] = __builtin_amdgcn_mfma_f32_16x16x32_f16(Af[ks], Bf, acc[tb], 0, 0, 0); } }
#pragma unroll
    for (int tb = 0; tb < 8; ++tb) { const int t = 16 * tb + fr; const float bs = inp(I_BSP)[head * 128 + t];
        const size_t ro = (size_t)(R0 + t); const int cc = head * 128 + 16 * wave + 4 * g;
        const u32x2 uw = *(const u32x2*)(Z + ro * INC + 3 * CW + cc); const f16x2 u0 = as_h2(uw.x), u1 = as_h2(uw.y);
        u32x2 w; w.x = pk16((float)u0[0] * (acc[tb][0] + bs), (float)u0[1] * (acc[tb][1] + bs)); w.y = pk16((float)u1[0] * (acc[tb][2] + bs), (float)u1[1] * (acc[tb][3] + bs));
        *(u32x2*)(Y + ro * DM + CW + cc) = w; }
    __syncthreads();
}

__device__ __forceinline__ void attn_unit(const Args& a, LAS unsigned char* lds, int b, int h, int qb, int tid, int wave, int lane) {
    const f16_t* Q = (const f16_t*)(a.ws + WS_XA); const f16_t* KV = (const f16_t*)(a.ws + WS_KV); f16_t* O = (f16_t*)(a.ws + WS_XB);
    const int fr = lane & 15, g = lane >> 4;
    const int R0 = b * SEQ + qb * 128 + wave * 16;
    f16x8 Qf[16];
    { const f16_t* qp = Q + (size_t)(R0 + fr) * DM + h * XHD + 8 * g;
#pragma unroll
      for (int kk = 0; kk < 16; ++kk) Qf[kk] = *(const f16x8*)(qp + 32 * kk); }
    const int srow = tid >> 3, sc = tid & 7;
    const f16_t* kbase = KV + (size_t)(b * NMEM + srow) * (2 * DM) + h * XHD + sc * 8;
    const unsigned swoff = (unsigned)(srow * 128 + ((sc ^ (srow & 7)) << 4));
    u32x4 st[4];
#define AT_LOAD(c) do { const f16_t* _p = kbase + ((c) >= 8 ? DM : 0) + 64 * ((c) & 7); _Pragma("unroll") for (int _i = 0; _i < 4; ++_i) st[_i] = *(const u32x4*)(_p + (size_t)_i * 64 * (2 * DM)); } while (0)
#define AT_WRITE(buf) do { _Pragma("unroll") for (int _i = 0; _i < 4; ++_i) *(LAS u32x4*)(lds + (buf) * 32768 + swoff + _i * 8192) = st[_i]; } while (0)
    AT_LOAD(0); AT_WRITE(0); __syncthreads();
    f32x4 S[16];
#pragma unroll
    for (int i = 0; i < 16; ++i) S[i] = (f32x4){0.f, 0.f, 0.f, 0.f};
    unsigned aoffK[2];
#pragma unroll
    for (int ks = 0; ks < 2; ++ks) aoffK[ks] = (unsigned)(fr * 128 + (((4 * ks + g) ^ (fr & 7)) << 4));
#pragma unroll
    for (int dc = 0; dc < 8; ++dc) {
        AT_LOAD(dc + 1);
        const LAS unsigned char* bp = lds + (dc & 1) * 32768;
#pragma unroll
        for (int mt = 0; mt < 16; ++mt)
#pragma unroll
            for (int ks = 0; ks < 2; ++ks) S[mt] = __builtin_amdgcn_mfma_f32_16x16x32_f16(*(const LAS f16x8*)(bp + mt * 2048 + aoffK[ks]), Qf[2 * dc + ks], S[mt], 0, 0, 0);
        AT_WRITE((dc + 1) & 1); __syncthreads();
    }
    float mx = S[0][0];
#pragma unroll
    for (int i = 0; i < 16; ++i) mx = fmaxf(fmaxf(mx, fmaxf(S[i][0], S[i][1])), fmaxf(S[i][2], S[i][3]));
    mx = fmaxf(mx, __shfl_xor(mx, 16)); mx = fmaxf(mx, __shfl_xor(mx, 32));
    float l = 0.f;
#pragma unroll
    for (int i = 0; i < 16; ++i)
#pragma unroll
        for (int r = 0; r < 4; ++r) { const float p = __builtin_amdgcn_exp2f(S[i][r] - mx); S[i][r] = p; l += p; }
    l += __shfl_xor(l, 16); l += __shfl_xor(l, 32);
    const float inv_l = 1.0f / l;
    f16x8 Pf[8];
#pragma unroll
    for (int ks = 0; ks < 8; ++ks) { u32x4 w; w.x = pk16(S[2 * ks][0], S[2 * ks][1]); w.y = pk16(S[2 * ks][2], S[2 * ks][3]); w.z = pk16(S[2 * ks + 1][0], S[2 * ks + 1][1]); w.w = pk16(S[2 * ks + 1][2], S[2 * ks + 1][3]);
        Pf[ks] = __builtin_bit_cast(f16x8, w); }
    const int q4 = fr >> 2, p4 = fr & 3;
    unsigned voff[4];
#pragma unroll
    for (int dt = 0; dt < 4; ++dt) voff[dt] = (unsigned)((4 * g + q4) * 128 + (((2 * dt + (p4 >> 1)) ^ (((g & 1) << 2) + q4)) << 4) + (p4 & 1) * 8);
    f16_t* orow = O + (size_t)(R0 + fr) * DM + h * XHD + 4 * g;
    for (int dc = 0; dc < 8; ++dc) {
        if (dc < 7) AT_LOAD(dc + 9);
        const LAS unsigned char* bp = lds + (dc & 1) * 32768;
#pragma unroll
        for (int dt = 0; dt < 4; ++dt) { f32x4 o = (f32x4){0.f, 0.f, 0.f, 0.f};
#pragma unroll
            for (int ks = 0; ks < 8; ++ks) {
                const fp16x4v t1 = __builtin_amdgcn_ds_read_tr16_b64_v4f16((LAS fp16x4v*)(bp + ks * 4096 + voff[dt]));
                const fp16x4v t2 = __builtin_amdgcn_ds_read_tr16_b64_v4f16((LAS fp16x4v*)(bp + ks * 4096 + 2048 + voff[dt]));
                const u32x2 w1 = __builtin_bit_cast(u32x2, t1), w2 = __builtin_bit_cast(u32x2, t2); const u32x4 w = {w1.x, w1.y, w2.x, w2.y};
                o = __builtin_amdgcn_mfma_f32_16x16x32_f16(__builtin_bit_cast(f16x8, w), Pf[ks], o, 0, 0, 0); }
            u32x2 w; w.x = pk16(o[0] * inv_l, o[1] * inv_l); w.y = pk16(o[2] * inv_l, o[3] * inv_l);
            *(u32x2*)(orow + 64 * dc + 16 * dt) = w; }
        if (dc < 7) AT_WRITE((dc + 1) & 1);
        __syncthreads();
    }
#undef AT_LOAD
#undef AT_WRITE
}

__global__ void __launch_bounds__(512, 2) mk_fwd(Args a) {
    extern __shared__ __attribute__((aligned(16))) unsigned char lds_raw[];
    LAS unsigned char* lds = (LAS unsigned char*)lds_raw;
    volatile LAS unsigned* MISC = (volatile LAS unsigned*)(lds + MISC_OFF);
    const int G = gridDim.x, bx = blockIdx.x;
#define OPAQUE_TID() int tid = threadIdx.x; asm volatile("" : "+v"(tid)); const int lane = tid & 63, wave = __builtin_amdgcn_readfirstlane(tid >> 6); (void)lane; (void)wave
    const int vcu = (G % 8 == 0) ? (bx % 8) * (G / 8) + bx / 8 : bx;
    unsigned char* ws = a.ws;
    if (threadIdx.x < 64) MISC[threadIdx.x] = 0u;
    __syncthreads();
    XcdBarrier bar; bar.bar = (unsigned*)(ws + WS_CTL) + CW_BAR; bar.x = 0; bar.st = nullptr;
    if (!MK_PER_STEP) bar = xcd_barrier_post((unsigned*)(ws + WS_CTL) + CW_BAR, MISC + 8);

    float* H = a.out;
    f16_t* XA = (f16_t*)(ws + WS_XA); f16_t* XB = (f16_t*)(ws + WS_XB); f16_t* ACT = (f16_t*)(ws + WS_ACT);
    float* P1 = (float*)(ws + WS_PART1); float* P2 = (float*)(ws + WS_PART2); float* P3 = (float*)(ws + WS_PART3);

    for (int st = a.lo; st < a.hi; ++st) {
      const int nrep = ((MK_REP_MASK >> st) & 1) ? 2 : 1;
      for (int rep = 0; rep < nrep; ++rep) {
        if (st == ST_PREP) { OPAQUE_TID(); step_prep(a, lds, G, vcu, tid, wave, lane); }
        else if (st == ST_G1 || st == ST_G7) {
            pg8::Gemm g{XA, (const f16_t*)(ws + (st == ST_G1 ? WS_W1IN : WS_W2IN)), TROWS, 2 * DFF, DM}; pg8::StaticOrder S; S.init(TROWS, 2 * DFF, G, bx);
            pg8::EpiSwiGLU E{ACT, st == ST_G1 ? nullptr : P3};
            pg8::gemm_phase(lds, g, S, E);
        } else if (st == ST_G2 || st == ST_G4 || st == ST_G6 || st == ST_G8) {
            const f16_t* A; const f16_t* Bt; int K; const float* base; f16_t* HG; const float* gn; float* part; float alpha;
            if (st == ST_G2)      { A = ACT; Bt = (const f16_t*)(ws + WS_W1OUT);  K = DFF; base = inp(I_X); HG = XB;      gn = inp(I_GMIX);   part = P1;      alpha = 0.5f; }
            else if (st == ST_G4) { A = XA;  Bt = (const f16_t*)(ws + WS_WMIXOUT); K = DM;  base = H;         HG = XB;      gn = inp(I_GXATTN); part = P2;      alpha = 1.0f; }
            else if (st == ST_G6) { A = XB;  Bt = (const f16_t*)(ws + WS_WO);      K = DM;  base = H;         HG = XA;      gn = inp(I_GFFN2);  part = P3;      alpha = 1.0f; }
            else                  { A = ACT; Bt = (const f16_t*)(ws + WS_W2OUT);  K = DFF; base = H;         HG = nullptr; gn = nullptr;        part = nullptr; alpha = 0.5f; }
            pg8::Gemm g{A, Bt, TROWS, DM, K}; pg8::StaticOrder S; S.init(TROWS, DM, G, bx);
            pg8::EpiRes E{base, (rep + 1 < nrep) ? (float*)(ws + WS_END) : H, HG, gn, part, alpha};
            pg8::gemm_phase(lds, g, S, E);
        } else if (st == ST_G3 || st == ST_G5 || st == ST_KV) {
            const f16_t* A; const f16_t* Bt; int M, N, ldc, c; f16_t* O; const float* part; float scale;
            if (st == ST_G3)      { A = XB; Bt = (const f16_t*)(ws + WS_WMIXIN); M = TROWS; N = INC;    O = ACT; ldc = INC;    part = P1; scale = 1.0f; c = bx; }
            else if (st == ST_G5) { A = XB; Bt = (const f16_t*)(ws + WS_WQ);     M = TROWS; N = DM;     O = XA;  ldc = DM;     part = P2; scale = 0.04419417382f * 1.44269504089f; c = bx; }
            else                  { A = (const f16_t*)(ws + WS_MEMN); Bt = (const f16_t*)(ws + WS_WKV); M = MROWS; N = 2 * DM; O = (f16_t*)(ws + WS_KV); ldc = 2 * DM; part = nullptr; scale = 1.0f; c = (bx + G / 2) % G; }
            pg8::Gemm g{A, Bt, M, N, DM}; pg8::StaticOrder S; S.init(M, N, G, c);
            pg8::EpiF16 E{O, ldc, part, scale};
            pg8::gemm_phase(lds, g, S, E);
        } else if (st == ST_MIX) {
            OPAQUE_TID();
            for (int u = vcu; u < TROWS / 32; u += G) conv_unit(a, u, tid);
            for (int u = vcu; u < (TROWS / 128) * 8; u += G) gm_unit(a, lds, u, tid, wave, lane);
        } else if (st == ST_ATT) {
            OPAQUE_TID();
            for (int u = bx; u < NB * XH * (SEQ / 128); u += G) { const int pair = u & 7, qb = u >> 3; attn_unit(a, lds, pair >> 2, pair & 3, qb, tid, wave, lane); }
        } else if (st == ST_FIN) {
            OPAQUE_TID();
            const int gw = vcu * 8 + wave, NGW = G * 8;
            for (int m = gw; m < TROWS; m += NGW) {
                f32x4* xr = (f32x4*)(H + (size_t)m * DM) + lane; const f32x4* gr = (const f32x4*)inp(I_GFINAL) + lane;
                f32x4 v[8]; float s = 0.f;
#pragma unroll
                for (int j = 0; j < 8; ++j) { v[j] = xr[64 * j]; s += (v[j][0] * v[j][0] + v[j][1] * v[j][1]) + (v[j][2] * v[j][2] + v[j][3] * v[j][3]); }
                const float rs = __builtin_amdgcn_rsqf(wave_sum(s) * (1.f / DM) + EPS);
#pragma unroll
                for (int j = 0; j < 8; ++j) xr[64 * j] = v[j] * rs * gr[64 * j];
            }
        }
        if (!MK_PER_STEP && rep + 1 < nrep) xcd_barrier(bar);
      }
        if (!MK_PER_STEP && st + 1 < a.hi && st != ST_G3) { for (int br = 0; br < MK_BAR_REP; ++br) xcd_barrier(bar); }
    }
}


#ifndef MK_DEBUG
#define MK_DEBUG 0
#endif
#if MK_DEBUG
constexpr size_t WS_HOLD = 356 * MiB;
__device__ __forceinline__ unsigned hash32(unsigned x) { x ^= x >> 16; x *= 0x7feb352du; x ^= x >> 15; x *= 0x846ca68bu; x ^= x >> 16; return x; }
__device__ __forceinline__ float r16(float v) { return (float)(_Float16)v; }
__device__ __forceinline__ bool bad(float got, float ref) { return !(fabsf(got - ref) <= 0.02f * fabsf(ref) + 0.02f); }
__device__ __forceinline__ float rs_of_row(const float* H, int r) { float s = 0.f; for (int c = 0; c < DM; ++c) s += H[(size_t)r * DM + c] * H[(size_t)r * DM + c]; return 1.0f / sqrtf(s / DM + EPS); }
__global__ void chk_step(Args a, int st, unsigned* flags) {
    const unsigned char* ws = a.ws; const unsigned sid = blockIdx.x * blockDim.x + threadIdx.x; const unsigned h1 = hash32(sid * 2654435761u + 12345u + st * 977u), h2 = hash32(h1 + 0x9e3779b9u);
    const float* H = a.out; const float* HOLD = (const float*)(ws + WS_HOLD);
    const f16_t* XA = (const f16_t*)(ws + WS_XA); const f16_t* XB = (const f16_t*)(ws + WS_XB); const f16_t* ACT = (const f16_t*)(ws + WS_ACT);
    bool f = false;
    if (st == ST_PREP) {
        const int which = sid % 13;
        if (which < 10) {
            int ii, K, N; size_t off;
            switch (which) { case 0: ii = I_W1IN; K = DM; N = 2 * DFF; off = WS_W1IN; break; case 1: ii = I_W1OUT; K = DFF; N = DM; off = WS_W1OUT; break; case 2: ii = I_WMIXIN; K = DM; N = INC; off = WS_WMIXIN; break;
                case 3: ii = I_WMIXOUT; K = DM; N = DM; off = WS_WMIXOUT; break; case 4: ii = I_WQ; K = DM; N = DM; off = WS_WQ; break; case 5: ii = I_WK; K = DM; N = DM; off = WS_WKV; break;
                case 6: ii = I_WV; K = DM; N = DM; off = WS_WKV; break; case 7: ii = I_WO; K = DM; N = DM; off = WS_WO; break; case 8: ii = I_W2IN; K = DM; N = 2 * DFF; off = WS_W2IN; break; default: ii = I_W2OUT; K = DFF; N = DM; off = WS_W2OUT; break; }
            const float* Wsrc = a.in[0]; for (int q = 0; q < 23; ++q) if (q == ii) Wsrc = a.in[q];
            const int k = h1 % K, n = h2 % N; int row = n;
            if (which == 0 || which == 8) { const int up = n >= DFF, nn = n - up * DFF; row = (nn >> 7) * 256 + up * 128 + (nn & 127); }
            if (which == 6) row = n + DM;
            const float ref = r16(Wsrc[(size_t)k * N + n]), got = (float)((const f16_t*)(ws + off))[(size_t)row * K + k];
            f = !(fabsf(got - ref) <= 1e-6f);
        } else if (which == 10) { const int r = h1 % TROWS, c = h2 % DM; float s = 0.f; for (int j = 0; j < DM; ++j) { const float v = a.in[I_X][(size_t)r * DM + j]; s += v * v; }
            f = bad((float)XA[(size_t)r * DM + c], a.in[I_X][(size_t)r * DM + c] / sqrtf(s / DM + EPS) * a.in[I_GFFN1][c]);
        } else if (which == 11) { const int r = h1 % MROWS, c = h2 % DM; float s = 0.f; for (int j = 0; j < DM; ++j) { const float v = a.in[I_MEM][(size_t)r * DM + j]; s += v * v; }
            f = bad((float)((const f16_t*)(ws + WS_MEMN))[(size_t)r * DM + c], a.in[I_MEM][(size_t)r * DM + c] / sqrtf(s / DM + EPS) * a.in[I_GMEM][c]);
        } else { const int i = h1 % (8 * 128 * 128), t = (i >> 7) & 127, s = i & 127; f = bad((float)((const f16_t*)(ws + WS_WSP))[i], s <= t ? a.in[I_WSP][i] : 0.f); }
    } else if (st == ST_G1 || st == ST_G7) {
        const int r = h1 % TROWS, j = h2 % DFF; const float* W = a.in[st == ST_G1 ? I_W1IN : I_W2IN]; float g = 0.f, u = 0.f;
        for (int k = 0; k < DM; ++k) { const float x = (float)XA[(size_t)r * DM + k]; g += x * r16(W[(size_t)k * (2 * DFF) + j]); u += x * r16(W[(size_t)k * (2 * DFF) + DFF + j]); }
        if (st == ST_G7) { const float rs = rs_of_row(H, r); g *= rs; u *= rs; }
        f = bad((float)ACT[(size_t)r * DFF + j], g / (1.f + expf(-g)) * u);
    } else if (st == ST_G2 || st == ST_G4 || st == ST_G6 || st == ST_G8) {
        const int r = h1 % TROWS, c = h2 % DM; const f16_t* A; int K; const float* W; const float* base; const f16_t* HG; const float* gn; const float* part; float alpha;
        if (st == ST_G2)      { A = ACT; K = DFF; W = a.in[I_W1OUT];  base = a.in[I_X]; HG = XB; gn = a.in[I_GMIX];   part = (const float*)(ws + WS_PART1); alpha = 0.5f; }
        else if (st == ST_G4) { A = XA;  K = DM;  W = a.in[I_WMIXOUT]; base = HOLD;      HG = XB; gn = a.in[I_GXATTN]; part = (const float*)(ws + WS_PART2); alpha = 1.f; }
        else if (st == ST_G6) { A = XB;  K = DM;  W = a.in[I_WO];      base = HOLD;      HG = XA; gn = a.in[I_GFFN2];  part = (const float*)(ws + WS_PART3); alpha = 1.f; }
        else                  { A = ACT; K = DFF; W = a.in[I_W2OUT];  base = HOLD;      HG = nullptr; gn = nullptr; part = nullptr; alpha = 0.5f; }
        float s = 0.f; for (int k = 0; k < K; ++k) s += (float)A[(size_t)r * K + k] * r16(W[(size_t)k * DM + c]);
        const float ref = base[(size_t)r * DM + c] + alpha * s; f = bad(H[(size_t)r * DM + c], ref);
        if (HG) f = f || bad((float)HG[(size_t)r * DM + c], H[(size_t)r * DM + c] * gn[c]);
        if (part) { float ps = 0.f; for (int j = 0; j < NPART; ++j) ps += part[(size_t)r * NPART + j]; float hs = 0.f; for (int j = 0; j < DM; ++j) hs += H[(size_t)r * DM + j] * H[(size_t)r * DM + j]; f = f || bad(ps, hs); }
    } else if (st == ST_G3 || st == ST_G5) {
        const int N = st == ST_G3 ? INC : DM; const int r = h1 % TROWS, n = h2 % N; const float* W = a.in[st == ST_G3 ? I_WMIXIN : I_WQ]; const f16_t* O = st == ST_G3 ? ACT : XA;
        float s = 0.f; for (int k = 0; k < DM; ++k) s += (float)XB[(size_t)r * DM + k] * r16(W[(size_t)k * N + n]);
        s *= rs_of_row(H, r); if (st == ST_G5) s *= 0.04419417382f * 1.44269504089f;
        f = bad((float)O[(size_t)r * N + n], s);
    } else if (st == ST_KV) {
        const int r = h1 % MROWS, n = h2 % (2 * DM); const float* W = a.in[n < DM ? I_WK : I_WV]; const int nn = n % DM; const f16_t* MN = (const f16_t*)(ws + WS_MEMN);
        float s = 0.f; for (int k = 0; k < DM; ++k) s += (float)MN[(size_t)r * DM + k] * r16(W[(size_t)k * DM + nn]);
        f = bad((float)((const f16_t*)(ws + WS_KV))[(size_t)r * 2 * DM + n], s);
    } else if (st == ST_MIX) {
        const int r = h1 % TROWS, c = h2 % DM, t = r & (SEQ - 1); const f16_t* Z = ACT; float ref;
        if (c < CW) { float acc = a.in[I_CONVB][c];
            for (int k = 0; k < 3; ++k) { const int tt = t - 2 + k; if (tt >= 0) { const size_t rr = (size_t)(r - 2 + k) * INC; acc += a.in[I_CONVW][k * CW + c] * (float)Z[rr + CW + c] * (float)Z[rr + 2 * CW + c]; } }
            ref = (float)Z[(size_t)r * INC + c] * acc;
        } else { const int cc = c - CW, head = cc >> 7, R0 = r & ~127, tq = r & 127; float sg = a.in[I_BSP][head * 128 + tq];
            for (int s = 0; s <= tq; ++s) { float ss = 0.f; for (int j = 0; j < 128; ++j) { const float v = (float)Z[(size_t)(R0 + s) * INC + 4 * CW + head * 128 + j]; ss += v * v; }
                const float vn = (float)Z[(size_t)(R0 + s) * INC + 4 * CW + cc] / sqrtf(ss / 128.f + EPS) * a.in[I_GGMV][cc]; sg += a.in[I_WSP][(size_t)head * 128 * 128 + tq * 128 + s] * vn; }
            ref = (float)Z[(size_t)r * INC + 3 * CW + cc] * sg; }
        f = bad((float)XA[(size_t)r * DM + c], ref);
    } else if (st == ST_ATT) {
        const int r = h1 % TROWS, c = h2 % DM, hh = c / XHD, b = r / SEQ; const f16_t* KV = (const f16_t*)(ws + WS_KV);
        float mx = -1e30f;
        for (int m = 0; m < NMEM; ++m) { float s = 0.f; for (int d = 0; d < XHD; ++d) s += (float)XA[(size_t)r * DM + hh * XHD + d] * (float)KV[(size_t)(b * NMEM + m) * 2 * DM + hh * XHD + d]; mx = fmaxf(mx, s); }
        float l = 0.f, o = 0.f;
        for (int m = 0; m < NMEM; ++m) { float s = 0.f; for (int d = 0; d < XHD; ++d) s += (float)XA[(size_t)r * DM + hh * XHD + d] * (float)KV[(size_t)(b * NMEM + m) * 2 * DM + hh * XHD + d];
            const float p = exp2f(s - mx); l += p; o += p * (float)KV[(size_t)(b * NMEM + m) * 2 * DM + DM + c]; }
        f = bad((float)XB[(size_t)r * DM + c], o / l);
    } else if (st == ST_FIN) {
        const int r = h1 % TROWS, c = h2 % DM; f = bad(H[(size_t)r * DM + c], HOLD[(size_t)r * DM + c] * rs_of_row(HOLD, r) * a.in[I_GFINAL][c]);
    }
    if (f) atomicOr(flags, 1u << st);
}
__global__ void chk_final(float* out, const unsigned* flags) {
    const size_t i = (size_t)blockIdx.x * blockDim.x + threadIdx.x;
    if (i < (size_t)TROWS * DM) out[i] = 0.f;
    if (i == 0) { const unsigned fl = *flags; int code = 0; for (int s = ST_N - 1; s >= 0; --s) if ((fl >> s) & 1u) code = s + 1; out[0] = (10.f + code) * 100.f; }
}
#endif

extern "C" void kernel_launch(void* const* d_in, const int* in_sizes, int n_in, void* d_out, int out_size, void* d_ws, size_t ws_size, hipStream_t stream) {
    static int grid = 0;
    if (grid == 0) {
        if (n_in != 23 || in_sizes[0] != TROWS * DM || out_size != TROWS * DM || ws_size < WS_END + ((MK_DEBUG || MK_REP_MASK) ? 64 * MiB : 0)) {
            fprintf(stderr, "kernel_launch: built for 23 inputs, x/out of %d floats, >= %zu bytes of workspace; got n_in %d, in0 %d, out %d, ws %zu; nothing launched\n", TROWS * DM, (size_t)WS_END, n_in, n_in > 0 ? in_sizes[0] : -1, out_size, ws_size); grid = -1; return; }
        int dev = 0, cus = 0, per_cu = 0;
        if (hipGetDevice(&dev) != hipSuccess || hipDeviceGetAttribute(&cus, hipDeviceAttributeMultiprocessorCount, dev) != hipSuccess) { fprintf(stderr, "kernel_launch: device query failed\n"); grid = -1; return; }
        if (hipFuncSetAttribute((const void*)mk_fwd, hipFuncAttributeMaxDynamicSharedMemorySize, LDS_BYTES) != hipSuccess) { fprintf(stderr, "kernel_launch: hipFuncSetAttribute failed\n"); grid = -1; return; }
        if (hipOccupancyMaxActiveBlocksPerMultiprocessor(&per_cu, (const void*)mk_fwd, 512, LDS_BYTES) != hipSuccess || per_cu < 1) { fprintf(stderr, "kernel_launch: occupancy query reports %d blocks per CU; nothing launched\n", per_cu); (void)hipGetLastError(); grid = -1; return; }
        grid = cus;
    }
    if (grid < 0) return;
    if (hipMemsetAsync((char*)d_ws + WS_CTL, 0, CTL_ZERO_BYTES, stream) != hipSuccess) { fprintf(stderr, "kernel_launch: memset failed\n"); return; }
    Args a{};
    for (int i = 0; i < 23; ++i) a.in[i] = (const float*)d_in[i];
    a.out = (float*)d_out; a.ws = (unsigned char*)d_ws;
#if MK_PER_STEP
    for (int s = 0; s < ST_N; ++s) { a.lo = s; a.hi = s + 1;
#if MK_DEBUG
        if (s == ST_G4 || s == ST_G6 || s == ST_G8 || s == ST_FIN) (void)hipMemcpyAsync((char*)d_ws + WS_HOLD, d_out, (size_t)TROWS * DM * 4, hipMemcpyDeviceToDevice, stream);
#endif
        hipLaunchKernelGGL(mk_fwd, dim3(grid), dim3(512), LDS_BYTES, stream, a);
#if MK_DEBUG
        hipLaunchKernelGGL(chk_step, dim3(16), dim3(256), 0, stream, a, s, (unsigned*)d_ws + 64);
#endif
    }
#if MK_DEBUG
    hipLaunchKernelGGL(chk_final, dim3(TROWS * DM / 256), dim3(256), 0, stream, (float*)d_out, (const unsigned*)d_ws + 64);
#endif
#else
    a.lo = 0; a.hi = ST_N;
    hipLaunchKernelGGL(mk_fwd, dim3(grid), dim3(512), LDS_BYTES, stream, a);
#endif
    const hipError_t le = hipPeekAtLastError();
    if (le != hipSuccess) fprintf(stderr, "kernel_launch: launch failed: %s\n", hipGetErrorName(le));
}
```

```cpp
#include <hip/hip_runtime.h>
#include <cstdio>
#include <cstdint>

#ifndef MK_REP_MASK
#define MK_REP_MASK 0
#endif
#ifndef MK_BAR_REP
#define MK_BAR_REP 1
#endif
#ifndef MK_PROBE_AT
#define MK_PROBE_AT -1
#endif
#ifndef MK_PROBE_KIND
#define MK_PROBE_KIND 0
#endif
#ifndef MK_PROBE_MA
#define MK_PROBE_MA -1
#endif
#ifndef MK_PROBE_MB
#define MK_PROBE_MB -1
#endif
#ifndef MK_PER_STEP
#define MK_PER_STEP 0
#endif

#define LAS __attribute__((address_space(3)))
typedef _Float16 f16_t;
typedef _Float16 f16x8 __attribute__((ext_vector_type(8)));
typedef _Float16 f16x2 __attribute__((ext_vector_type(2)));
typedef __fp16 fp16x4v __attribute__((__vector_size__(4 * sizeof(__fp16))));
typedef float f32x4 __attribute__((ext_vector_type(4)));
typedef unsigned u32x4 __attribute__((ext_vector_type(4)));
typedef unsigned u32x2 __attribute__((ext_vector_type(2)));

constexpr int NB = 2, SEQ = 4096, DM = 2048, TROWS = NB * SEQ;
constexpr int DFF = 5632, INC = 5120, CW = 1024, GMW = 1024, NMEM = 256, MROWS = NB * NMEM;
constexpr int XH = 4, XHD = 512;
constexpr float EPS = 1e-6f;
constexpr int NPART = 32;

__device__ __forceinline__ unsigned pk16(float a, float b) { f16x2 v = {(_Float16)a, (_Float16)b}; return __builtin_bit_cast(unsigned, v); }
__device__ __forceinline__ f16x2 as_h2(unsigned u) { const unsigned t = u; return __builtin_bit_cast(f16x2, t); }

namespace pg8 {
constexpr int BM = 256, BK = 64, HALF = 128, HTB = HALF * BK * 2  , STAGE_BYTES = 8 * HTB, NXCD = 8, WGM = 8;
__host__ __device__ __forceinline__ int lds_byte(int r, int c) { const int st = (r >> 4) * 2 + (c >> 5), rr = r & 15, cc = c & 31, ob = rr * 64 + cc * 2; return st * 1024 + (ob ^ (((ob >> 9) & 1) << 5)); }
__host__ __device__ __forceinline__ void stage_rc(int b, int& R, int& C) { const int st = b / 1024, sb = b % 1024, swz = sb ^ (((sb >> 9) & 1) << 5); R = (st >> 1) * 16 + swz / 64; C = (st & 1) * 32 + (swz % 64) / 2; }
__host__ __device__ __forceinline__ int perm32(int rho) { const int n = rho >> 4, i = rho & 15; return 8 * (i >> 2) + 4 * n + (i & 3); }

struct Unit { int pm, pn; };
struct Gemm { const f16_t* A; const f16_t* Bt; int M, N, K; int mA = -1, mB = -1; };

struct StaticOrder {
    int nM, nN, nwg, G, c;
    __device__ void init(int M, int N, int G_, int c_) { nM = M / BM; nN = N / BM; nwg = nM * nN; G = G_; c = c_; }
    __device__ bool next(int i, Unit& u) const {
        const long L = (long)i * G + c; if (L >= nwg) return false;
        int wgid = (int)L; { const int q = nwg / NXCD, r = nwg % NXCD, xcd = wgid % NXCD, off = wgid / NXCD; wgid = (xcd < r ? xcd * (q + 1) : r * (q + 1) + (xcd - r) * q) + off; }
        const int nig = WGM * nN, gid = wgid / nig, fm = gid * WGM, gsz = (nM - fm) < WGM ? (nM - fm) : WGM;
        u.pm = fm + ((wgid % nig) % gsz); u.pn = (wgid % nig) / gsz; return true;
    }
};

__device__ __forceinline__ void row_rs(const float* part, int pm, int wr, int lane, float (&rsv)[2]) {
#pragma unroll
    for (int ai = 0; ai < 2; ++ai) {
        const f32x4* p = (const f32x4*)(part + (size_t)(pm * BM + ai * HALF + wr * 64 + lane) * NPART);
        f32x4 s = p[0];
#pragma unroll
        for (int j = 1; j < NPART / 4; ++j) s += p[j];
        rsv[ai] = __builtin_amdgcn_rsqf(((s[0] + s[1]) + (s[2] + s[3])) * (1.0f / DM) + EPS);
    }
}

struct EpiF16 {
    f16_t* O; int ldc; const float* part; float scale;
    __device__ __forceinline__ void operator()(const f32x4 (&acc)[2][2][4][2], const Unit& u, int wr, int wc, int fr, int fq) const {
        const int lane = fq * 16 + fr; float rsv[2] = {1.f, 1.f};
        if (part) row_rs(part, u.pm, wr, lane, rsv);
        const int row0 = u.pm * BM + wr * 64 + fr, col0 = u.pn * BM + wc * 32 + 8 * fq;
#pragma unroll
        for (int ai = 0; ai < 2; ++ai)
#pragma unroll
            for (int m = 0; m < 4; ++m) {
                float s = scale; if (part) s *= __shfl(rsv[ai], m * 16 + fr);
                f16_t* rowp = O + (size_t)(row0 + ai * HALF + m * 16) * ldc + col0;
#pragma unroll
                for (int bj = 0; bj < 2; ++bj) { const f32x4 v0 = acc[ai][bj][m][0] * s, v1 = acc[ai][bj][m][1] * s;
                    u32x4 w; w.x = pk16(v0[0], v0[1]); w.y = pk16(v0[2], v0[3]); w.z = pk16(v1[0], v1[1]); w.w = pk16(v1[2], v1[3]);
                    *(u32x4*)(rowp + bj * HALF) = w; } }
    }
};
struct EpiSwiGLU {
    f16_t* O; const float* part;
    __device__ __forceinline__ void operator()(const f32x4 (&acc)[2][2][4][2], const Unit& u, int wr, int wc, int fr, int fq) const {
        const int lane = fq * 16 + fr; float rsv[2] = {1.f, 1.f};
        if (part) row_rs(part, u.pm, wr, lane, rsv);
        const int row0 = u.pm * BM + wr * 64 + fr, col0 = u.pn * HALF + wc * 32 + 8 * fq;
#pragma unroll
        for (int ai = 0; ai < 2; ++ai)
#pragma unroll
            for (int m = 0; m < 4; ++m) {
                float s = 1.f; if (part) s = __shfl(rsv[ai], m * 16 + fr);
                float o[8];
#pragma unroll
                for (int n = 0; n < 2; ++n)
#pragma unroll
                    for (int j = 0; j < 4; ++j) { const float g = acc[ai][0][m][n][j] * s, up = acc[ai][1][m][n][j] * s;
                        const float e = __builtin_amdgcn_exp2f(g * -1.44269504089f); o[n * 4 + j] = g * __builtin_amdgcn_rcpf(1.0f + e) * up; }
                u32x4 w; w.x = pk16(o[0], o[1]); w.y = pk16(o[2], o[3]); w.z = pk16(o[4], o[5]); w.w = pk16(o[6], o[7]);
                *(u32x4*)(O + (size_t)(row0 + ai * HALF + m * 16) * DFF + col0) = w; }
    }
};
struct EpiRes {
    const float* base32; const f16_t* base16; f16_t* HH; float* part; float alpha;
    __device__ __forceinline__ void operator()(const f32x4 (&acc)[2][2][4][2], const Unit& u, int wr, int wc, int fr, int fq) const {
        const int row0 = u.pm * BM + wr * 64 + fr, col0 = u.pn * BM + wc * 32 + 8 * fq;
#pragma unroll
        for (int ai = 0; ai < 2; ++ai)
#pragma unroll
            for (int m = 0; m < 4; ++m) {
                const int row = row0 + ai * HALF + m * 16; const size_t off = (size_t)row * DM + col0; float ss = 0.f;
#pragma unroll
                for (int bj = 0; bj < 2; ++bj) {
                    f32x4 b0, b1;
                    if (base32) { b0 = *(const f32x4*)(base32 + off + bj * HALF); b1 = *(const f32x4*)(base32 + off + bj * HALF + 4); }
                    else { const u32x4 bw = *(const u32x4*)(base16 + off + bj * HALF); const f16x2 p0 = as_h2(bw.x), p1 = as_h2(bw.y), p2 = as_h2(bw.z), p3 = as_h2(bw.w);
                        b0 = (f32x4){(float)p0[0], (float)p0[1], (float)p1[0], (float)p1[1]}; b1 = (f32x4){(float)p2[0], (float)p2[1], (float)p3[0], (float)p3[1]}; }
                    const f32x4 h0 = b0 + acc[ai][bj][m][0] * alpha, h1 = b1 + acc[ai][bj][m][1] * alpha;
                    ss += (h0[0] * h0[0] + h0[1] * h0[1]) + (h0[2] * h0[2] + h0[3] * h0[3]) + (h1[0] * h1[0] + h1[1] * h1[1]) + (h1[2] * h1[2] + h1[3] * h1[3]);
                    u32x4 w; w.x = pk16(h0[0], h0[1]); w.y = pk16(h0[2], h0[3]); w.z = pk16(h1[0], h1[1]); w.w = pk16(h1[2], h1[3]);
                    *(u32x4*)(HH + off + bj * HALF) = w; }
                ss += __shfl_xor(ss, 16); ss += __shfl_xor(ss, 32);
                if (part && fq == 0) part[(size_t)row * NPART + u.pn * 4 + wc] = ss; }
    }
};

template <class Epi>
__device__ __forceinline__ void gemm_phase(LAS unsigned char* lds, const Gemm g, const StaticOrder& S, const Epi& E) {
    int tid_ = threadIdx.x; asm volatile("" : "+v"(tid_));
    const int tid = tid_, wid = __builtin_amdgcn_readfirstlane(tid >> 6), lane = tid & 63, wr = wid >> 2, wc = wid & 3, fr = lane & 15, fq = lane >> 4;
    const int K = g.K, nt = K / BK;
    unsigned voffA[2], voffB[2];
#pragma unroll
    for (int i = 0; i < 2; ++i) { int R, C; stage_rc(tid * 16 + i * 8192, R, C); const int Rb = (R & ~31) + perm32(R & 31);
        voffA[i] = (unsigned)(R * K + C) * 2u; voffB[i] = (unsigned)(Rb * K + C) * 2u; }
    const size_t kstep = (size_t)(BK * 2);
    const size_t hstep = (size_t)HALF * K * 2;
    const size_t tstep = 2 * hstep;
    const unsigned ldsw = (unsigned)wid * 1024u;
    const int aoff = lds_byte(wr * 64 + fr, fq * 8), boff = lds_byte(wc * 32 + fr, fq * 8);
#define PG8_SA(b, h) (((b) * 2 + (h)) * HTB)
#define PG8_SB(b, h) ((4 + (b) * 2 + (h)) * HTB)
#define PG8_STAGE(bufoff, gbase, voff) do { _Pragma("unroll") for (int _i = 0; _i < 2; ++_i) \
        __builtin_amdgcn_global_load_lds((const unsigned*)((const char*)(gbase) + (voff)[_i]), (LAS unsigned*)(lds + (bufoff) + ldsw + _i * 8192), 16, 0, 0); } while (0)
#define PG8_LDA(dst, b, h) do { _Pragma("unroll") for (int m = 0; m < 4; ++m) _Pragma("unroll") for (int k = 0; k < 2; ++k) dst[m][k] = *(const LAS f16x8*)(lds + PG8_SA(b, h) + aoff + m * 2048 + k * 1024); } while (0)
#define PG8_LDB(dst, b, h) do { _Pragma("unroll") for (int n = 0; n < 2; ++n) _Pragma("unroll") for (int k = 0; k < 2; ++k) dst[n][k] = *(const LAS f16x8*)(lds + PG8_SB(b, h) + boff + n * 2048 + k * 1024); } while (0)
#define PG8_MMA(ai, bj, At, Bt) do { __builtin_amdgcn_s_setprio(1); _Pragma("unroll") for (int m = 0; m < 4; ++m) _Pragma("unroll") for (int n = 0; n < 2; ++n) _Pragma("unroll") for (int k = 0; k < 2; ++k) \
        acc[ai][bj][m][n] = __builtin_amdgcn_mfma_f32_16x16x32_f16(Bt[n][k], At[m][k], acc[ai][bj][m][n], 0, 0, 0); __builtin_amdgcn_s_setprio(0); } while (0)
#define PG8_WAIT_V(n) asm volatile("s_waitcnt vmcnt(" #n ")" ::: "memory")
#define PG8_WAIT_L(n) asm volatile("s_waitcnt lgkmcnt(" #n ")" ::: "memory")
#define PG8_BAR __builtin_amdgcn_s_barrier()
#define PG8_SCHED __builtin_amdgcn_sched_barrier(0)
    Unit cur, nxt; int ui = 0;
    if (!S.next(0, cur)) return;
    f32x4 acc[2][2][4][2];
#pragma unroll
    for (int a = 0; a < 2; ++a)
#pragma unroll
        for (int b = 0; b < 2; ++b)
#pragma unroll
            for (int m = 0; m < 4; ++m)
#pragma unroll
                for (int n = 0; n < 2; ++n) acc[a][b][m][n] = (f32x4){0.f, 0.f, 0.f, 0.f};
    f16x8 At[4][2], B0[2][2], B1[2][2];
    const char* cA = (const char*)g.A + (size_t)(cur.pm & g.mA) * tstep; const char* cB = (const char*)g.Bt + (size_t)(cur.pn & g.mB) * tstep;
    PG8_STAGE(PG8_SB(0, 0), cB, voffB); PG8_STAGE(PG8_SB(0, 1), cB + hstep, voffB); PG8_STAGE(PG8_SA(0, 0), cA, voffA); PG8_STAGE(PG8_SA(0, 1), cA + hstep, voffA);
    if (wr == 1) PG8_BAR;
    PG8_WAIT_V(2); PG8_BAR;
    PG8_STAGE(PG8_SB(1, 0), cB + kstep, voffB); PG8_STAGE(PG8_SA(1, 0), cA + kstep, voffA); PG8_STAGE(PG8_SB(1, 1), cB + hstep + kstep, voffB);
    PG8_WAIT_V(6); PG8_BAR;
    for (;;) {
        const bool has_next = S.next(ui + 1, nxt);
        const char* nA = has_next ? (const char*)g.A + (size_t)(nxt.pm & g.mA) * tstep : cA; const char* nB = has_next ? (const char*)g.Bt + (size_t)(nxt.pn & g.mB) * tstep : cB;
        for (int t = 0; t < nt; t += 2) {
            const bool last = (t == nt - 2);
            const char* a1 = cA + (size_t)(t + 1) * kstep;
            const char* a2 = last ? nA : cA + (size_t)(t + 2) * kstep; const char* b2 = last ? nB : cB + (size_t)(t + 2) * kstep;
            const char* a3 = a2 + kstep; const char* b3 = b2 + kstep;
            PG8_LDB(B0, 0, 0); PG8_LDB(B1, 0, 1); PG8_SCHED; PG8_LDA(At, 0, 0); PG8_STAGE(PG8_SA(1, 1), a1 + hstep, voffA);
            PG8_WAIT_V(8); PG8_WAIT_L(0); PG8_BAR; PG8_MMA(0, 0, At, B0); PG8_MMA(0, 1, At, B1); PG8_BAR; PG8_SCHED;
            PG8_LDA(At, 0, 1); PG8_STAGE(PG8_SB(0, 0), b2, voffB); PG8_STAGE(PG8_SB(0, 1), b2 + hstep, voffB); PG8_STAGE(PG8_SA(0, 0), a2, voffA);
            PG8_WAIT_V(8); PG8_WAIT_L(0); PG8_BAR; PG8_MMA(1, 0, At, B0); PG8_MMA(1, 1, At, B1); PG8_BAR; PG8_SCHED;
            PG8_LDB(B0, 1, 0); PG8_LDB(B1, 1, 1); PG8_SCHED; PG8_LDA(At, 1, 0); PG8_STAGE(PG8_SA(0, 1), a2 + hstep, voffA);
            PG8_WAIT_V(8); PG8_WAIT_L(0); PG8_BAR; PG8_MMA(0, 0, At, B0); PG8_MMA(0, 1, At, B1); PG8_BAR; PG8_SCHED;
            PG8_LDA(At, 1, 1); PG8_STAGE(PG8_SB(1, 0), b3, voffB); PG8_STAGE(PG8_SB(1, 1), b3 + hstep, voffB); PG8_STAGE(PG8_SA(1, 0), a3, voffA);
            PG8_WAIT_V(8); PG8_WAIT_L(0); PG8_BAR; PG8_MMA(1, 0, At, B0); PG8_MMA(1, 1, At, B1); PG8_BAR; PG8_SCHED;
        }
        if (wr == 0) PG8_BAR;
        E(acc, cur, wr, wc, fr, fq);
        if (!has_next) break;
#pragma unroll
        for (int a = 0; a < 2; ++a)
#pragma unroll
            for (int b = 0; b < 2; ++b)
#pragma unroll
                for (int m = 0; m < 4; ++m)
#pragma unroll
                    for (int n = 0; n < 2; ++n) acc[a][b][m][n] = (f32x4){0.f, 0.f, 0.f, 0.f};
        cur = nxt; cA = nA; cB = nB; ++ui;
        if (wr == 1) PG8_BAR;
    }
    PG8_WAIT_V(0);
    PG8_BAR;
#undef PG8_SA
#undef PG8_SB
#undef PG8_STAGE
#undef PG8_LDA
#undef PG8_LDB
#undef PG8_MMA
#undef PG8_WAIT_V
#undef PG8_WAIT_L
#undef PG8_BAR
#undef PG8_SCHED
}
}

constexpr size_t MiB = 1u << 20;
constexpr size_t WS_CTL = 0, CTL_ZERO_BYTES = 64 * 1024;
constexpr size_t WS_PART1 = 1 * MiB, WS_PART2 = 2 * MiB, WS_PART3 = 3 * MiB;
constexpr size_t WS_WSP = 4 * MiB;
constexpr size_t WS_MEMN = 5 * MiB;
constexpr size_t WS_KV = 7 * MiB;
constexpr size_t WS_W1IN = 12 * MiB, WS_W1OUT = 56 * MiB, WS_WMIXIN = 78 * MiB, WS_WMIXOUT = 98 * MiB, WS_WQ = 106 * MiB, WS_WKV = 114 * MiB,
                 WS_WO = 130 * MiB, WS_W2IN = 138 * MiB, WS_W2OUT = 182 * MiB;
constexpr size_t WS_XA = 204 * MiB, WS_XB = 236 * MiB;
constexpr size_t WS_ACT = 268 * MiB;
constexpr size_t WS_END = 356 * MiB;
constexpr int CW_BAR = 4096;

constexpr int RING_BYTES = 131072;
constexpr int PREP_SCR = 64 * 65 * 4;
constexpr int MISC_OFF = 8 * PREP_SCR;
constexpr int LDS_BYTES = 147456;

#define XB_TMO      128
#define XB_XCNT(j)  (256  + 64 * (j))
#define XB_XSUB(j)  (1280 + 64 * (j))
#define XB_XGEN(j)  (2304 + 64 * (j))
#define XB_TOP      3328
#define XB_TOPGEN   3392
#define XCD_BAR_WORDS 3456
#define XB_SPIN_CAP (1u << 20)
__device__ __forceinline__ unsigned xb_ld(unsigned* p)              { return __hip_atomic_load(p, __ATOMIC_RELAXED, __HIP_MEMORY_SCOPE_AGENT); }
__device__ __forceinline__ unsigned xb_add(unsigned* p, unsigned v) { return __hip_atomic_fetch_add(p, v, __ATOMIC_RELAXED, __HIP_MEMORY_SCOPE_AGENT); }
__device__ __forceinline__ unsigned xb_xcc_id() { return (unsigned)__builtin_amdgcn_s_getreg((3 << 11) | 20) & 0xFu; }
#define XB_SPIN(cond, bar) do { unsigned _sp = 0; while (cond) { __builtin_amdgcn_s_sleep(1); \
    if ((++_sp & 255u) == 0u) { if (xb_ld(&(bar)[XB_TMO])) break; if (_sp > XB_SPIN_CAP) { atomicAdd(&(bar)[XB_TMO], 1u); break; } } } } while (0)
struct XcdBarrier { unsigned* bar; unsigned x; volatile LAS unsigned* st; };
__device__ __forceinline__ XcdBarrier xcd_barrier_post(unsigned* bar, volatile LAS unsigned* st) {
    XcdBarrier b; b.bar = bar; b.x = xb_xcc_id(); b.st = st;
    if (threadIdx.x == 0) (void)xb_add(&bar[XB_XCNT(b.x)], 1u);
    return b;
}
__device__ __forceinline__ void xcd_barrier_complete(unsigned* bar, unsigned x, unsigned& nloc, unsigned& nx) {
    const unsigned G = gridDim.x * gridDim.y * gridDim.z;
    unsigned sum, cnt, mine, sp = 0u;
    for (;;) {
        sum = 0u; cnt = 0u; mine = 0u;
#pragma unroll
        for (unsigned j = 0; j < 16; ++j) { const unsigned c = xb_ld(&bar[XB_XCNT(j)]); sum += c; cnt += (c > 0u) ? 1u : 0u; mine = (j == x) ? c : mine; }
        if (sum == G) break;
        __builtin_amdgcn_s_sleep(1);
        if ((++sp & 255u) == 0u) { if (xb_ld(&bar[XB_TMO])) break; if (sp > XB_SPIN_CAP) { atomicAdd(&bar[XB_TMO], 1u); break; } }
    }
    nloc = mine > 0u ? mine : 1u; nx = cnt > 0u ? cnt : 1u;
}
__device__ __forceinline__ void xcd_barrier(const XcdBarrier& b) {
    asm volatile("s_waitcnt vmcnt(0)" ::: "memory");
    __syncthreads();
    if (threadIdx.x == 0) {
        unsigned* bar = b.bar;
        __builtin_amdgcn_s_waitcnt(0);
        unsigned nloc = b.st[0], nx = b.st[1];
        if (nloc == 0u) { xcd_barrier_complete(bar, b.x, nloc, nx); b.st[0] = nloc; b.st[1] = nx; }
        const unsigned old = xb_add(&bar[XB_XSUB(b.x)], 1u);
        const unsigned gen = old / nloc;
        if (old + 1u == (gen + 1u) * nloc) {
            __builtin_amdgcn_fence(__ATOMIC_RELEASE, "agent");
            asm volatile("s_waitcnt vmcnt(0)" ::: "memory");
            const unsigned og = xb_add(&bar[XB_TOP], 1u);
            const unsigned tg = og / nx;
            if (og + 1u == (tg + 1u) * nx) xb_add(&bar[XB_TOPGEN], 1u);
            else XB_SPIN(xb_ld(&bar[XB_TOPGEN]) == tg, bar);
            __builtin_amdgcn_fence(__ATOMIC_ACQUIRE, "agent");
            xb_add(&bar[XB_XGEN(b.x)], 1u);
            asm volatile("s_waitcnt vmcnt(0)" ::: "memory");
        } else {
            XB_SPIN(xb_ld(&bar[XB_XGEN(b.x)]) == gen, bar);
            __builtin_amdgcn_fence(__ATOMIC_ACQUIRE, "agent");
            asm volatile("s_waitcnt vmcnt(0)" ::: "memory");
        }
    }
    __syncthreads();
}

#define LDS_WAIT() asm volatile("s_waitcnt lgkmcnt(0)" ::: "memory")
__device__ __forceinline__ float wave_sum(float v) {
#pragma unroll
    for (int o = 1; o < 64; o <<= 1) v += __shfl_xor(v, o);
    return v;
}
__device__ __forceinline__ void transpose_item(const float* W, int N, f16_t* WT, int K, int dst_row0, int k0, int n0, const float* gk, LAS float* scr, int lane) {
    const int n4 = lane & 15, kq = lane >> 4;
    const float* src = W + (size_t)(k0 + kq) * N + n0 + 4 * n4;
    f32x4 v[16];
#pragma unroll
    for (int i = 0; i < 16; ++i) v[i] = *(const f32x4*)(src + (size_t)(4 * i) * N);
    if (gk) {
#pragma unroll
        for (int i = 0; i < 16; ++i) v[i] *= gk[k0 + 4 * i + kq]; }
#pragma unroll
    for (int i = 0; i < 16; ++i) { LAS float* d = scr + (4 * i + kq) * 65 + 4 * n4; d[0] = v[i][0]; d[1] = v[i][1]; d[2] = v[i][2]; d[3] = v[i][3]; }
    LDS_WAIT(); asm volatile("" ::: "memory");
    const int c = lane & 7;
#pragma unroll
    for (int j = 0; j < 8; ++j) { const int n = (lane >> 3) + 8 * j; const LAS float* s = scr + (8 * c) * 65 + n;
        u32x4 o; o.x = pk16(s[0 * 65], s[1 * 65]); o.y = pk16(s[2 * 65], s[3 * 65]); o.z = pk16(s[4 * 65], s[5 * 65]); o.w = pk16(s[6 * 65], s[7 * 65]);
        *(u32x4*)(WT + (size_t)(dst_row0 + n) * K + k0 + 8 * c) = o; }
    LDS_WAIT(); asm volatile("" ::: "memory");
}
__device__ __forceinline__ void prep_mat(const float* W, int K, int N, f16_t* WT, int row_off, bool ileave, const float* gk, int r, LAS float* scr, int lane) {
    const int nblk = N / 64, kb = r / nblk, nb = r - kb * nblk, n0 = 64 * nb;
    int dr;
    if (ileave) { const int half = N / 2, up = n0 >= half ? 1 : 0, nn = n0 - up * half; dr = (nn >> 7) * 256 + up * 128 + (nn & 127); } else dr = row_off + n0;
    transpose_item(W, N, WT, K, dr, 64 * kb, n0, gk, scr, lane);
}
__device__ __forceinline__ void norm_row_f16(const float* xrow, const float* g, f16_t* orow, int lane) {
    const f32x4* xr = (const f32x4*)xrow + lane; const f32x4* gr = (const f32x4*)g + lane;
    f32x4 v[8]; float s = 0.f;
#pragma unroll
    for (int j = 0; j < 8; ++j) { v[j] = xr[64 * j]; s += (v[j][0] * v[j][0] + v[j][1] * v[j][1]) + (v[j][2] * v[j][2] + v[j][3] * v[j][3]); }
    const float rs = __builtin_amdgcn_rsqf(wave_sum(s) * (1.f / DM) + EPS);
    u32x2* o8 = (u32x2*)orow + lane;
#pragma unroll
    for (int j = 0; j < 8; ++j) { const f32x4 gg = gr[64 * j]; u32x2 w; w.x = pk16(v[j][0] * rs * gg[0], v[j][1] * rs * gg[1]); w.y = pk16(v[j][2] * rs * gg[2], v[j][3] * rs * gg[3]); o8[64 * j] = w; }
}

struct Args { const float* in[23]; float* out; unsigned char* ws; int lo, hi; };
__device__ __forceinline__ const float* inp(int i) {
    const __attribute__((address_space(4))) unsigned long long* t = (const __attribute__((address_space(4))) unsigned long long*)__builtin_amdgcn_kernarg_segment_ptr();
    asm volatile("" : "+s"(i));
    return (const float*)t[i];
}
enum { I_X = 0, I_MEM, I_GFFN1, I_W1IN, I_W1OUT, I_GMIX, I_WMIXIN, I_CONVW, I_CONVB, I_GGMV, I_WSP, I_BSP, I_WMIXOUT, I_GXATTN, I_GMEM, I_WQ, I_WK, I_WV, I_WO, I_GFFN2, I_W2IN, I_W2OUT, I_GFINAL };
enum { ST_PREP = 0, ST_G1, ST_G2, ST_G3, ST_KV, ST_MIX, ST_G4, ST_G5, ST_ATT, ST_G6, ST_G7, ST_G8, ST_FIN, ST_N };

__device__ __forceinline__ void step_prep(const Args& a, LAS unsigned char* lds, int G, int vcu, int tid, int wave, int lane) {
    unsigned char* ws = a.ws;
    LAS float* scr = (LAS float*)(lds + wave * PREP_SCR);
    const int gw = vcu * 8 + wave, NGW = G * 8;
    constexpr int I_FIN = (DM / 64) * (2 * DFF / 64), I_FOUT = (DFF / 64) * (DM / 64), I_MIXIN = (DM / 64) * (INC / 64), I_SQ = (DM / 64) * (DM / 64);
    constexpr int NITEMS = 2 * I_FIN + 2 * I_FOUT + I_MIXIN + 5 * I_SQ;
    for (int it = gw; it < NITEMS; it += NGW) {
        int r = it;
        if (r < I_FIN) { prep_mat(inp(I_W1IN), DM, 2 * DFF, (f16_t*)(ws + WS_W1IN), 0, true, nullptr, r, scr, lane); continue; } r -= I_FIN;
        if (r < I_FOUT) { prep_mat(inp(I_W1OUT), DFF, DM, (f16_t*)(ws + WS_W1OUT), 0, false, nullptr, r, scr, lane); continue; } r -= I_FOUT;
        if (r < I_MIXIN) { prep_mat(inp(I_WMIXIN), DM, INC, (f16_t*)(ws + WS_WMIXIN), 0, false, inp(I_GMIX), r, scr, lane); continue; } r -= I_MIXIN;
        if (r < I_SQ) { prep_mat(inp(I_WMIXOUT), DM, DM, (f16_t*)(ws + WS_WMIXOUT), 0, false, nullptr, r, scr, lane); continue; } r -= I_SQ;
        if (r < I_SQ) { prep_mat(inp(I_WQ), DM, DM, (f16_t*)(ws + WS_WQ), 0, false, inp(I_GXATTN), r, scr, lane); continue; } r -= I_SQ;
        if (r < I_SQ) { prep_mat(inp(I_WK), DM, DM, (f16_t*)(ws + WS_WKV), 0, false, nullptr, r, scr, lane); continue; } r -= I_SQ;
        if (r < I_SQ) { prep_mat(inp(I_WV), DM, DM, (f16_t*)(ws + WS_WKV), DM, false, nullptr, r, scr, lane); continue; } r -= I_SQ;
        if (r < I_SQ) { prep_mat(inp(I_WO), DM, DM, (f16_t*)(ws + WS_WO), 0, false, nullptr, r, scr, lane); continue; } r -= I_SQ;
        if (r < I_FIN) { prep_mat(inp(I_W2IN), DM, 2 * DFF, (f16_t*)(ws + WS_W2IN), 0, true, inp(I_GFFN2), r, scr, lane); continue; } r -= I_FIN;
        prep_mat(inp(I_W2OUT), DFF, DM, (f16_t*)(ws + WS_W2OUT), 0, false, nullptr, r, scr, lane);
    }
    for (int m = gw; m < TROWS; m += NGW) norm_row_f16(inp(I_X) + (size_t)m * DM, inp(I_GFFN1), (f16_t*)(ws + WS_XA) + (size_t)m * DM, lane);
    for (int m = gw; m < MROWS; m += NGW) norm_row_f16(inp(I_MEM) + (size_t)m * DM, inp(I_GMEM), (f16_t*)(ws + WS_MEMN) + (size_t)m * DM, lane);
    { const f32x4* src = (const f32x4*)inp(I_WSP); u32x2* dst = (u32x2*)(ws + WS_WSP);
      for (int i = vcu * 512 + tid; i < 8 * 128 * 128 / 4; i += G * 512) { const int t = (i >> 5) & 127, s0 = (i & 31) * 4; const f32x4 v = src[i];
          u32x2 w; w.x = pk16(s0 <= t ? v[0] : 0.f, s0 + 1 <= t ? v[1] : 0.f); w.y = pk16(s0 + 2 <= t ? v[2] : 0.f, s0 + 3 <= t ? v[3] : 0.f); dst[i] = w; } }
}

__device__ __forceinline__ void f16x8_to_f32(const u32x4 w, float (&f)[8]) {
#pragma unroll
    for (int j = 0; j < 4; ++j) { const f16x2 h = as_h2(w[j]); f[2 * j] = (float)h[0]; f[2 * j + 1] = (float)h[1]; }
}
__device__ __forceinline__ void conv_unit(const Args& a, int cu, int tid) {
    const f16_t* Z = (const f16_t*)(a.ws + WS_ACT); f16_t* Y = (f16_t*)(a.ws + WS_XA);
    const int cg = tid & 127, rg = tid >> 7, c = 8 * cg, r0 = 32 * cu + 8 * rg;
    float w0[8], w1[8], w2[8], cb[8];
    { const f32x4* p = (const f32x4*)(inp(I_CONVW) + c); const f32x4 a0 = p[0], a1 = p[1], b0 = p[CW / 4], b1 = p[CW / 4 + 1], c0 = p[2 * CW / 4], c1 = p[2 * CW / 4 + 1];
      const f32x4* q = (const f32x4*)(inp(I_CONVB) + c); const f32x4 d0 = q[0], d1 = q[1];
#pragma unroll
      for (int j = 0; j < 4; ++j) { w0[j] = a0[j]; w0[4 + j] = a1[j]; w1[j] = b0[j]; w1[4 + j] = b1[j]; w2[j] = c0[j]; w2[4 + j] = c1[j]; cb[j] = d0[j]; cb[4 + j] = d1[j]; } }
    float m2[8], m1[8];
    const bool first = (r0 & (SEQ - 1)) == 0;
    {
        float x[8], y[8];
        if (!first) {
            f16x8_to_f32(*(const u32x4*)(Z + (size_t)(r0 - 2) * INC + CW + c), x); f16x8_to_f32(*(const u32x4*)(Z + (size_t)(r0 - 2) * INC + 2 * CW + c), y);
#pragma unroll
            for (int j = 0; j < 8; ++j) m2[j] = x[j] * y[j];
            f16x8_to_f32(*(const u32x4*)(Z + (size_t)(r0 - 1) * INC + CW + c), x); f16x8_to_f32(*(const u32x4*)(Z + (size_t)(r0 - 1) * INC + 2 * CW + c), y);
#pragma unroll
            for (int j = 0; j < 8; ++j) m1[j] = x[j] * y[j];
        } else {
#pragma unroll
            for (int j = 0; j < 8; ++j) { m2[j] = 0.f; m1[j] = 0.f; }
        }
    }
#pragma unroll
    for (int rr = 0; rr < 8; ++rr) {
        const size_t ro = (size_t)(r0 + rr) * INC + c;
        float gb[8], gc[8], hc[8], o[8];
        f16x8_to_f32(*(const u32x4*)(Z + ro), gb); f16x8_to_f32(*(const u32x4*)(Z + ro + CW), gc); f16x8_to_f32(*(const u32x4*)(Z + ro + 2 * CW), hc);
#pragma unroll
        for (int j = 0; j < 8; ++j) { const float ch = gc[j] * hc[j]; o[j] = gb[j] * (cb[j] + w2[j] * ch + w1[j] * m1[j] + w0[j] * m2[j]); m2[j] = m1[j]; m1[j] = ch; }
        u32x4 w; w.x = pk16(o[0], o[1]); w.y = pk16(o[2], o[3]); w.z = pk16(o[4], o[5]); w.w = pk16(o[6], o[7]);
        *(u32x4*)(Y + (size_t)(r0 + rr) * DM + c) = w;
    }
}
constexpr int VNT_PITCH = 272;
__device__ __forceinline__ void gm_unit(const Args& a, LAS unsigned char* lds, int gu, int tid, int wave, int lane) {
    const f16_t* Z = (const f16_t*)(a.ws + WS_ACT); f16_t* Y = (f16_t*)(a.ws + WS_XA); const f16_t* WSP = (const f16_t*)(a.ws + WS_WSP);
    const int head = gu & 7, R0 = (gu >> 3) * 128;
    { const int ch = tid & 15, sr = tid >> 4; float gg[8];
      { const f32x4* p = (const f32x4*)(inp(I_GGMV) + head * 128 + 8 * ch); const f32x4 g0 = p[0], g1 = p[1];
#pragma unroll
        for (int j = 0; j < 4; ++j) { gg[j] = g0[j]; gg[4 + j] = g1[j]; } }
#pragma unroll
      for (int ps = 0; ps < 4; ++ps) { const int s = sr + 32 * ps; float v[8];
          f16x8_to_f32(*(const u32x4*)(Z + (size_t)(R0 + s) * INC + 4 * CW + head * 128 + 8 * ch), v);
          float ss = 0.f;
#pragma unroll
          for (int j = 0; j < 8; ++j) ss += v[j] * v[j];
          ss += __shfl_xor(ss, 1); ss += __shfl_xor(ss, 2); ss += __shfl_xor(ss, 4); ss += __shfl_xor(ss, 8);
          const float rs = __builtin_amdgcn_rsqf(ss * (1.f / 128.f) + EPS);
#pragma unroll
          for (int j = 0; j < 8; ++j) *(LAS f16_t*)(lds + (8 * ch + j) * VNT_PITCH + 2 * s) = (f16_t)(v[j] * rs * gg[j]); } }
    __syncthreads();
    const int fr = lane & 15, g = lane >> 4;
    f16x8 Af[4];
#pragma unroll
    for (int ks = 0; ks < 4; ++ks) Af[ks] = *(const LAS f16x8*)(lds + (16 * wave + fr) * VNT_PITCH + (32 * ks + 8 * g) * 2);
    f32x4 acc[8];
    const f16_t* wrow = WSP + (size_t)head * 128 * 128 + (size_t)fr * 128 + 8 * g;
#pragma unroll
    for (int tb = 0; tb < 8; ++tb) { acc[tb] = (f32x4){0.f, 0.f, 0.f, 0.f};
#pragma unroll
        for (int ks = 0; ks < 4; ++ks) if (32 * ks <= 16 * tb + 15) { const f16x8 Bf = *(const f16x8*)(wrow + (size_t)tb * 16 * 128 + 32 * ks);
            acc[tb] = __builtin_amdgcn_mfma_f32_16x16x32_f16(Af[ks], Bf, acc[tb], 0, 0, 0); } }
#pragma unroll
    for (int tb = 0; tb < 8; ++tb) { const int t = 16 * tb + fr; const float bs = inp(I_BSP)[head * 128 + t];
        const size_t ro = (size_t)(R0 + t); const int cc = head * 128 + 16 * wave + 4 * g;
        const u32x2 uw = *(const u32x2*)(Z + ro * INC + 3 * CW + cc); const f16x2 u0 = as_h2(uw.x), u1 = as_h2(uw.y);
        u32x2 w; w.x = pk16((float)u0[0] * (acc[tb][0] + bs), (float)u0[1] * (acc[tb][1] + bs)); w.y = pk16((float)u1[0] * (acc[tb][2] + bs), (float)u1[1] * (acc[tb][3] + bs));
        *(u32x2*)(Y + ro * DM + CW + cc) = w; }
    __syncthreads();
}

__device__ __forceinline__ void attn_unit(const Args& a, LAS unsigned char* lds, int b, int h, int qb, int tid, int wave, int lane) {
    const f16_t* Q = (const f16_t*)(a.ws + WS_XA); const f16_t* KV = (const f16_t*)(a.ws + WS_KV); f16_t* O = (f16_t*)(a.ws + WS_ACT);
    const int fr = lane & 15, g = lane >> 4;
    const int R0 = b * SEQ + qb * 128 + wave * 16;
    f16x8 Qf[16];
    { const f16_t* qp = Q + (size_t)(R0 + fr) * DM + h * XHD + 8 * g;
#pragma unroll
      for (int kk = 0; kk < 16; ++kk) Qf[kk] = *(const f16x8*)(qp + 32 * kk); }
    const int srow = tid >> 3, sc = tid & 7;
    const f16_t* kbase = KV + (size_t)(b * NMEM + srow) * (2 * DM) + h * XHD + sc * 8;
    const unsigned swoff = (unsigned)(srow * 128 + ((sc ^ (srow & 7)) << 4));
    u32x4 st[4];
#define AT_LOAD(c) do { const f16_t* _p = kbase + ((c) >= 8 ? DM : 0) + 64 * ((c) & 7); _Pragma("unroll") for (int _i = 0; _i < 4; ++_i) st[_i] = *(const u32x4*)(_p + (size_t)_i * 64 * (2 * DM)); } while (0)
#define AT_WRITE(buf) do { _Pragma("unroll") for (int _i = 0; _i < 4; ++_i) *(LAS u32x4*)(lds + (buf) * 32768 + swoff + _i * 8192) = st[_i]; } while (0)
    AT_LOAD(0); AT_WRITE(0); __syncthreads();
    f32x4 S[16];
#pragma unroll
    for (int i = 0; i < 16; ++i) S[i] = (f32x4){0.f, 0.f, 0.f, 0.f};
    unsigned aoffK[2];
#pragma unroll
    for (int ks = 0; ks < 2; ++ks) aoffK[ks] = (unsigned)(fr * 128 + (((4 * ks + g) ^ (fr & 7)) << 4));
#pragma unroll
    for (int dc = 0; dc < 8; ++dc) {
        AT_LOAD(dc + 1);
        const LAS unsigned char* bp = lds + (dc & 1) * 32768;
#pragma unroll
        for (int mt = 0; mt < 16; ++mt)
#pragma unroll
            for (int ks = 0; ks < 2; ++ks) S[mt] = __builtin_amdgcn_mfma_f32_16x16x32_f16(*(const LAS f16x8*)(bp + mt * 2048 + aoffK[ks]), Qf[2 * dc + ks], S[mt], 0, 0, 0);
        AT_WRITE((dc + 1) & 1); __syncthreads();
    }
    float mx = S[0][0];
#pragma unroll
    for (int i = 0; i < 16; ++i) mx = fmaxf(fmaxf(mx, fmaxf(S[i][0], S[i][1])), fmaxf(S[i][2], S[i][3]));
    mx = fmaxf(mx, __shfl_xor(mx, 16)); mx = fmaxf(mx, __shfl_xor(mx, 32));
    float l = 0.f;
#pragma unroll
    for (int i = 0; i < 16; ++i)
#pragma unroll
        for (int r = 0; r < 4; ++r) { const float p = __builtin_amdgcn_exp2f(S[i][r] - mx); S[i][r] = p; l += p; }
    l += __shfl_xor(l, 16); l += __shfl_xor(l, 32);
    const float inv_l = 1.0f / l;
    f16x8 Pf[8];
#pragma unroll
    for (int ks = 0; ks < 8; ++ks) { u32x4 w; w.x = pk16(S[2 * ks][0], S[2 * ks][1]); w.y = pk16(S[2 * ks][2], S[2 * ks][3]); w.z = pk16(S[2 * ks + 1][0], S[2 * ks + 1][1]); w.w = pk16(S[2 * ks + 1][2], S[2 * ks + 1][3]);
        Pf[ks] = __builtin_bit_cast(f16x8, w); }
    const int q4 = fr >> 2, p4 = fr & 3;
    unsigned voff[4];
#pragma unroll
    for (int dt = 0; dt < 4; ++dt) voff[dt] = (unsigned)((4 * g + q4) * 128 + (((2 * dt + (p4 >> 1)) ^ (((g & 1) << 2) + q4)) << 4) + (p4 & 1) * 8);
    f16_t* orow = O + (size_t)(R0 + fr) * DM + h * XHD + 4 * g;
    for (int dc = 0; dc < 8; ++dc) {
        if (dc < 7) AT_LOAD(dc + 9);
        const LAS unsigned char* bp = lds + (dc & 1) * 32768;
#pragma unroll
        for (int dt = 0; dt < 4; ++dt) { f32x4 o = (f32x4){0.f, 0.f, 0.f, 0.f};
#pragma unroll
            for (int ks = 0; ks < 8; ++ks) {
                const fp16x4v t1 = __builtin_amdgcn_ds_read_tr16_b64_v4f16((LAS fp16x4v*)(bp + ks * 4096 + voff[dt]));
                const fp16x4v t2 = __builtin_amdgcn_ds_read_tr16_b64_v4f16((LAS fp16x4v*)(bp + ks * 4096 + 2048 + voff[dt]));
                const u32x2 w1 = __builtin_bit_cast(u32x2, t1), w2 = __builtin_bit_cast(u32x2, t2); const u32x4 w = {w1.x, w1.y, w2.x, w2.y};
                o = __builtin_amdgcn_mfma_f32_16x16x32_f16(__builtin_bit_cast(f16x8, w), Pf[ks], o, 0, 0, 0); }
            u32x2 w; w.x = pk16(o[0] * inv_l, o[1] * inv_l); w.y = pk16(o[2] * inv_l, o[3] * inv_l);
            *(u32x2*)(orow + 64 * dc + 16 * dt) = w; }
        if (dc < 7) AT_WRITE((dc + 1) & 1);
        __syncthreads();
    }
#undef AT_LOAD
#undef AT_WRITE
}

__global__ void __launch_bounds__(512, 2) mk_fwd(Args a) {
    extern __shared__ __attribute__((aligned(16))) unsigned char lds_raw[];
    LAS unsigned char* lds = (LAS unsigned char*)lds_raw;
    volatile LAS unsigned* MISC = (volatile LAS unsigned*)(lds + MISC_OFF);
    const int G = gridDim.x, bx = blockIdx.x;
#define OPAQUE_TID() int tid = threadIdx.x; asm volatile("" : "+v"(tid)); const int lane = tid & 63, wave = __builtin_amdgcn_readfirstlane(tid >> 6); (void)lane; (void)wave
    const int vcu = (G % 8 == 0) ? (bx % 8) * (G / 8) + bx / 8 : bx;
    unsigned char* ws = a.ws;
    if (threadIdx.x < 64) MISC[threadIdx.x] = 0u;
    __syncthreads();
    XcdBarrier bar; bar.bar = (unsigned*)(ws + WS_CTL) + CW_BAR; bar.x = 0; bar.st = nullptr;
    if (!MK_PER_STEP) bar = xcd_barrier_post((unsigned*)(ws + WS_CTL) + CW_BAR, MISC + 8);

    f16_t* XA = (f16_t*)(ws + WS_XA); f16_t* XB = (f16_t*)(ws + WS_XB); f16_t* ACT = (f16_t*)(ws + WS_ACT);
    f16_t* XC = ACT;
    float* P1 = (float*)(ws + WS_PART1); float* P2 = (float*)(ws + WS_PART2); float* P3 = (float*)(ws + WS_PART3);

    for (int st = a.lo; st < a.hi; ++st) {
      const int nrep = ((MK_REP_MASK >> st) & 1) ? 2 : 1;
      for (int rep = 0; rep < nrep; ++rep) {
        if (st == ST_PREP) { OPAQUE_TID(); step_prep(a, lds, G, vcu, tid, wave, lane); }
        else if (st == ST_G1 || st == ST_G7) {
            pg8::Gemm g{st == ST_G1 ? XA : XB, (const f16_t*)(ws + (st == ST_G1 ? WS_W1IN : WS_W2IN)), TROWS, 2 * DFF, DM}; pg8::StaticOrder S; S.init(TROWS, 2 * DFF, G, bx);
            pg8::EpiSwiGLU E{ACT, st == ST_G1 ? nullptr : P3};
            pg8::gemm_phase(lds, g, S, E);
        } else if (st == ST_G2 || st == ST_G4 || st == ST_G6 || st == ST_G8) {
            const f16_t* A; const f16_t* Bt; int K; const float* b32; float* part; float alpha;
            if (st == ST_G2)      { A = ACT; Bt = (const f16_t*)(ws + WS_W1OUT);   K = DFF; b32 = inp(I_X); part = P1;      alpha = 0.5f; }
            else if (st == ST_G4) { A = XA;  Bt = (const f16_t*)(ws + WS_WMIXOUT); K = DM;  b32 = nullptr;  part = P2;      alpha = 1.0f; }
            else if (st == ST_G6) { A = XC;  Bt = (const f16_t*)(ws + WS_WO);      K = DM;  b32 = nullptr;  part = P3;      alpha = 1.0f; }
            else                  { A = ACT; Bt = (const f16_t*)(ws + WS_W2OUT);   K = DFF; b32 = nullptr;  part = nullptr; alpha = 0.5f; }
            pg8::Gemm g{A, Bt, TROWS, DM, K}; pg8::StaticOrder S; S.init(TROWS, DM, G, bx);
            pg8::EpiRes E{b32, XB, (rep + 1 < nrep) ? (f16_t*)(ws + WS_END) : XB, part, alpha};
            pg8::gemm_phase(lds, g, S, E);
        } else if (st == ST_G3 || st == ST_G5 || st == ST_KV) {
            const f16_t* A; const f16_t* Bt; int M, N, ldc, c; f16_t* O; const float* part; float scale;
            if (st == ST_G3)      { A = XB; Bt = (const f16_t*)(ws + WS_WMIXIN); M = TROWS; N = INC;    O = ACT; ldc = INC;    part = P1; scale = 1.0f; c = bx; }
            else if (st == ST_G5) { A = XB; Bt = (const f16_t*)(ws + WS_WQ);     M = TROWS; N = DM;     O = XA;  ldc = DM;     part = P2; scale = 0.04419417382f * 1.44269504089f; c = bx; }
            else                  { A = (const f16_t*)(ws + WS_MEMN); Bt = (const f16_t*)(ws + WS_WKV); M = MROWS; N = 2 * DM; O = (f16_t*)(ws + WS_KV); ldc = 2 * DM; part = nullptr; scale = 1.0f; c = (bx + G / 2) % G; }
            pg8::Gemm g{A, Bt, M, N, DM}; pg8::StaticOrder S; S.init(M, N, G, c);
            pg8::EpiF16 E{O, ldc, part, scale};
            pg8::gemm_phase(lds, g, S, E);
        } else if (st == ST_MIX) {
            OPAQUE_TID();
            for (int u = vcu; u < TROWS / 32; u += G) conv_unit(a, u, tid);
            for (int u = vcu; u < (TROWS / 128) * 8; u += G) gm_unit(a, lds, u, tid, wave, lane);
        } else if (st == ST_ATT) {
            OPAQUE_TID();
            for (int u = bx; u < NB * XH * (SEQ / 128); u += G) { const int pair = u & 7, qb = u >> 3; attn_unit(a, lds, pair >> 2, pair & 3, qb, tid, wave, lane); }
        } else if (st == ST_FIN) {
            OPAQUE_TID();
            const int gw = vcu * 8 + wave, NGW = G * 8;
            for (int m = gw; m < TROWS; m += NGW) {
                const u32x4* xr = (const u32x4*)(XB + (size_t)m * DM) + lane; const f32x4* gr = (const f32x4*)inp(I_GFINAL); f32x4* orow = (f32x4*)(a.out + (size_t)m * DM);
                float v[4][8]; float s = 0.f;
#pragma unroll
                for (int j = 0; j < 4; ++j) { f16x8_to_f32(xr[64 * j], v[j]);
#pragma unroll
                    for (int e = 0; e < 8; ++e) s += v[j][e] * v[j][e]; }
                const float rs = __builtin_amdgcn_rsqf(wave_sum(s) * (1.f / DM) + EPS);
#pragma unroll
                for (int j = 0; j < 4; ++j) { const int c4 = 2 * (lane + 64 * j); const f32x4 g0 = gr[c4], g1 = gr[c4 + 1];
                    orow[c4] = (f32x4){v[j][0] * rs * g0[0], v[j][1] * rs * g0[1], v[j][2] * rs * g0[2], v[j][3] * rs * g0[3]};
                    orow[c4 + 1] = (f32x4){v[j][4] * rs * g1[0], v[j][5] * rs * g1[1], v[j][6] * rs * g1[2], v[j][7] * rs * g1[3]}; }
            }
        }
        if (!MK_PER_STEP && rep + 1 < nrep) xcd_barrier(bar);
      }
        if (MK_PROBE_AT == st) {
            xcd_barrier(bar);
            pg8::Gemm g{MK_PROBE_KIND == 0 ? ACT : XA, (const f16_t*)(ws + (MK_PROBE_KIND == 0 ? WS_W1OUT : WS_WMIXOUT)), TROWS, DM, MK_PROBE_KIND == 0 ? DFF : DM, MK_PROBE_MA, MK_PROBE_MB};
            pg8::StaticOrder S; S.init(TROWS, DM, G, bx);
            pg8::EpiF16 E{(f16_t*)(ws + WS_END), DM, nullptr, 1.0f};
            pg8::gemm_phase(lds, g, S, E);
        }
        if (!MK_PER_STEP && st + 1 < a.hi && st != ST_G3) { for (int br = 0; br < MK_BAR_REP; ++br) xcd_barrier(bar); }
    }
}


#ifndef MK_DEBUG
#define MK_DEBUG 0
#endif
#if MK_DEBUG
constexpr size_t WS_HOLD = 388 * MiB;
__device__ __forceinline__ unsigned hash32(unsigned x) { x ^= x >> 16; x *= 0x7feb352du; x ^= x >> 15; x *= 0x846ca68bu; x ^= x >> 16; return x; }
__device__ __forceinline__ float r16(float v) { return (float)(_Float16)v; }
__device__ __forceinline__ bool bad(float got, float ref) { return !(fabsf(got - ref) <= 0.02f * fabsf(ref) + 0.02f); }
__device__ __forceinline__ float rs_of_row(const f16_t* H, int r) { float s = 0.f; for (int c = 0; c < DM; ++c) { const float v = (float)H[(size_t)r * DM + c]; s += v * v; } return 1.0f / sqrtf(s / DM + EPS); }
__global__ void chk_step(Args a, int st, unsigned* flags) {
    const unsigned char* ws = a.ws; const unsigned sid = blockIdx.x * blockDim.x + threadIdx.x; const unsigned h1 = hash32(sid * 2654435761u + 12345u + st * 977u), h2 = hash32(h1 + 0x9e3779b9u);
    const f16_t* HOLD = (const f16_t*)(ws + WS_HOLD);
    const f16_t* XA = (const f16_t*)(ws + WS_XA); const f16_t* XB = (const f16_t*)(ws + WS_XB); const f16_t* ACT = (const f16_t*)(ws + WS_ACT);
    bool f = false;
    if (st == ST_PREP) {
        const int which = sid % 13;
        if (which < 10) {
            int ii, K, N, gi = -1; size_t off;
            switch (which) { case 0: ii = I_W1IN; K = DM; N = 2 * DFF; off = WS_W1IN; break; case 1: ii = I_W1OUT; K = DFF; N = DM; off = WS_W1OUT; break; case 2: ii = I_WMIXIN; K = DM; N = INC; off = WS_WMIXIN; gi = I_GMIX; break;
                case 3: ii = I_WMIXOUT; K = DM; N = DM; off = WS_WMIXOUT; break; case 4: ii = I_WQ; K = DM; N = DM; off = WS_WQ; gi = I_GXATTN; break; case 5: ii = I_WK; K = DM; N = DM; off = WS_WKV; break;
                case 6: ii = I_WV; K = DM; N = DM; off = WS_WKV; break; case 7: ii = I_WO; K = DM; N = DM; off = WS_WO; break; case 8: ii = I_W2IN; K = DM; N = 2 * DFF; off = WS_W2IN; gi = I_GFFN2; break; default: ii = I_W2OUT; K = DFF; N = DM; off = WS_W2OUT; break; }
            const float* Wsrc = a.in[0]; const float* gsrc = nullptr; for (int q = 0; q < 23; ++q) { if (q == ii) Wsrc = a.in[q]; if (q == gi) gsrc = a.in[q]; }
            const int k = h1 % K, n = h2 % N; int row = n;
            if (which == 0 || which == 8) { const int up = n >= DFF, nn = n - up * DFF; row = (nn >> 7) * 256 + up * 128 + (nn & 127); }
            if (which == 6) row = n + DM;
            const float ref = r16(Wsrc[(size_t)k * N + n] * (gsrc ? gsrc[k] : 1.f)), got = (float)((const f16_t*)(ws + off))[(size_t)row * K + k];
            f = !(fabsf(got - ref) <= 1e-6f + 1e-3f * fabsf(ref));
        } else if (which == 10) { const int r = h1 % TROWS, c = h2 % DM; float s = 0.f; for (int j = 0; j < DM; ++j) { const float v = a.in[I_X][(size_t)r * DM + j]; s += v * v; }
            f = bad((float)XA[(size_t)r * DM + c], a.in[I_X][(size_t)r * DM + c] / sqrtf(s / DM + EPS) * a.in[I_GFFN1][c]);
        } else if (which == 11) { const int r = h1 % MROWS, c = h2 % DM; float s = 0.f; for (int j = 0; j < DM; ++j) { const float v = a.in[I_MEM][(size_t)r * DM + j]; s += v * v; }
            f = bad((float)((const f16_t*)(ws + WS_MEMN))[(size_t)r * DM + c], a.in[I_MEM][(size_t)r * DM + c] / sqrtf(s / DM + EPS) * a.in[I_GMEM][c]);
        } else { const int i = h1 % (8 * 128 * 128), t = (i >> 7) & 127, s = i & 127; f = bad((float)((const f16_t*)(ws + WS_WSP))[i], s <= t ? a.in[I_WSP][i] : 0.f); }
    } else if (st == ST_G1 || st == ST_G7) {
        const int r = h1 % TROWS, j = h2 % DFF; const float* W = a.in[st == ST_G1 ? I_W1IN : I_W2IN]; const f16_t* A = st == ST_G1 ? XA : XB; float g = 0.f, u = 0.f;
        for (int k = 0; k < DM; ++k) { const float x = (float)A[(size_t)r * DM + k], gg = st == ST_G7 ? a.in[I_GFFN2][k] : 1.f; g += x * r16(gg * W[(size_t)k * (2 * DFF) + j]); u += x * r16(gg * W[(size_t)k * (2 * DFF) + DFF + j]); }
        if (st == ST_G7) { const float rs = rs_of_row(XB, r); g *= rs; u *= rs; }
        f = bad((float)ACT[(size_t)r * DFF + j], g / (1.f + expf(-g)) * u);
    } else if (st == ST_G2 || st == ST_G4 || st == ST_G6 || st == ST_G8) {
        const int r = h1 % TROWS, c = h2 % DM; const f16_t* A; int K; const float* W; float base; const float* part; float alpha;
        if (st == ST_G2)      { A = ACT; K = DFF; W = a.in[I_W1OUT];  base = a.in[I_X][(size_t)r * DM + c];   part = (const float*)(ws + WS_PART1); alpha = 0.5f; }
        else if (st == ST_G4) { A = XA;  K = DM;  W = a.in[I_WMIXOUT]; base = (float)HOLD[(size_t)r * DM + c]; part = (const float*)(ws + WS_PART2); alpha = 1.f; }
        else if (st == ST_G6) { A = ACT; K = DM;  W = a.in[I_WO];      base = (float)HOLD[(size_t)r * DM + c]; part = (const float*)(ws + WS_PART3); alpha = 1.f; }
        else                  { A = ACT; K = DFF; W = a.in[I_W2OUT];  base = (float)HOLD[(size_t)r * DM + c]; part = nullptr; alpha = 0.5f; }
        float s = 0.f; for (int k = 0; k < K; ++k) s += (float)A[(size_t)r * K + k] * r16(W[(size_t)k * DM + c]);
        f = bad((float)XB[(size_t)r * DM + c], base + alpha * s);
        if (part) { float ps = 0.f; for (int j = 0; j < NPART; ++j) ps += part[(size_t)r * NPART + j]; float hs = 0.f; for (int j = 0; j < DM; ++j) { const float v = (float)XB[(size_t)r * DM + j]; hs += v * v; } f = f || bad(ps, hs); }
    } else if (st == ST_G3 || st == ST_G5) {
        const int N = st == ST_G3 ? INC : DM; const int r = h1 % TROWS, n = h2 % N; const float* W = a.in[st == ST_G3 ? I_WMIXIN : I_WQ]; const float* gg = a.in[st == ST_G3 ? I_GMIX : I_GXATTN]; const f16_t* O = st == ST_G3 ? ACT : XA;
        float s = 0.f; for (int k = 0; k < DM; ++k) s += (float)XB[(size_t)r * DM + k] * r16(gg[k] * W[(size_t)k * N + n]);
        s *= rs_of_row(XB, r); if (st == ST_G5) s *= 0.04419417382f * 1.44269504089f;
        f = bad((float)O[(size_t)r * N + n], s);
    } else if (st == ST_KV) {
        const int r = h1 % MROWS, n = h2 % (2 * DM); const float* W = a.in[n < DM ? I_WK : I_WV]; const int nn = n % DM; const f16_t* MN = (const f16_t*)(ws + WS_MEMN);
        float s = 0.f; for (int k = 0; k < DM; ++k) s += (float)MN[(size_t)r * DM + k] * r16(W[(size_t)k * DM + nn]);
        f = bad((float)((const f16_t*)(ws + WS_KV))[(size_t)r * 2 * DM + n], s);
    } else if (st == ST_MIX) {
        const int r = h1 % TROWS, c = h2 % DM, t = r & (SEQ - 1); const f16_t* Z = ACT; float ref;
        if (c < CW) { float acc = a.in[I_CONVB][c];
            for (int k = 0; k < 3; ++k) { const int tt = t - 2 + k; if (tt >= 0) { const size_t rr = (size_t)(r - 2 + k) * INC; acc += a.in[I_CONVW][k * CW + c] * (float)Z[rr + CW + c] * (float)Z[rr + 2 * CW + c]; } }
            ref = (float)Z[(size_t)r * INC + c] * acc;
        } else { const int cc = c - CW, head = cc >> 7, R0 = r & ~127, tq = r & 127; float sg = a.in[I_BSP][head * 128 + tq];
            for (int s = 0; s <= tq; ++s) { float ss = 0.f; for (int j = 0; j < 128; ++j) { const float v = (float)Z[(size_t)(R0 + s) * INC + 4 * CW + head * 128 + j]; ss += v * v; }
                const float vn = (float)Z[(size_t)(R0 + s) * INC + 4 * CW + cc] / sqrtf(ss / 128.f + EPS) * a.in[I_GGMV][cc]; sg += a.in[I_WSP][(size_t)head * 128 * 128 + tq * 128 + s] * vn; }
            ref = (float)Z[(size_t)r * INC + 3 * CW + cc] * sg; }
        f = bad((float)XA[(size_t)r * DM + c], ref);
    } else if (st == ST_ATT) {
        const int r = h1 % TROWS, c = h2 % DM, hh = c / XHD, b = r / SEQ; const f16_t* KV = (const f16_t*)(ws + WS_KV);
        float mx = -1e30f;
        for (int m = 0; m < NMEM; ++m) { float s = 0.f; for (int d = 0; d < XHD; ++d) s += (float)XA[(size_t)r * DM + hh * XHD + d] * (float)KV[(size_t)(b * NMEM + m) * 2 * DM + hh * XHD + d]; mx = fmaxf(mx, s); }
        float l = 0.f, o = 0.f;
        for (int m = 0; m < NMEM; ++m) { float s = 0.f; for (int d = 0; d < XHD; ++d) s += (float)XA[(size_t)r * DM + hh * XHD + d] * (float)KV[(size_t)(b * NMEM + m) * 2 * DM + hh * XHD + d];
            const float p = exp2f(s - mx); l += p; o += p * (float)KV[(size_t)(b * NMEM + m) * 2 * DM + DM + c]; }
        f = bad((float)ACT[(size_t)r * DM + c], o / l);
    } else if (st == ST_FIN) {
        const int r = h1 % TROWS, c = h2 % DM; f = bad(a.out[(size_t)r * DM + c], (float)XB[(size_t)r * DM + c] * rs_of_row(XB, r) * a.in[I_GFINAL][c]);
    }
    if (f) atomicOr(flags, 1u << st);
}
__global__ void chk_final(float* out, const unsigned* flags) {
    const size_t i = (size_t)blockIdx.x * blockDim.x + threadIdx.x;
    if (i < (size_t)TROWS * DM) out[i] = 0.f;
    if (i == 0) { const unsigned fl = *flags; int code = 0; for (int s = ST_N - 1; s >= 0; --s) if ((fl >> s) & 1u) code = s + 1; out[0] = (10.f + code) * 100.f; }
}
#endif

extern "C" void kernel_launch(void* const* d_in, const int* in_sizes, int n_in, void* d_out, int out_size, void* d_ws, size_t ws_size, hipStream_t stream) {
    static int grid = 0;
    if (grid == 0) {
        if (n_in != 23 || in_sizes[0] != TROWS * DM || out_size != TROWS * DM || ws_size < WS_END + ((MK_DEBUG || MK_REP_MASK || MK_PROBE_AT >= 0) ? 64 * MiB : 0)) {
            fprintf(stderr, "kernel_launch: built for 23 inputs, x/out of %d floats, >= %zu bytes of workspace; got n_in %d, in0 %d, out %d, ws %zu; nothing launched\n", TROWS * DM, (size_t)WS_END, n_in, n_in > 0 ? in_sizes[0] : -1, out_size, ws_size); grid = -1; return; }
        int dev = 0, cus = 0, per_cu = 0;
        if (hipGetDevice(&dev) != hipSuccess || hipDeviceGetAttribute(&cus, hipDeviceAttributeMultiprocessorCount, dev) != hipSuccess) { fprintf(stderr, "kernel_launch: device query failed\n"); grid = -1; return; }
        if (hipFuncSetAttribute((const void*)mk_fwd, hipFuncAttributeMaxDynamicSharedMemorySize, LDS_BYTES) != hipSuccess) { fprintf(stderr, "kernel_launch: hipFuncSetAttribute failed\n"); grid = -1; return; }
        if (hipOccupancyMaxActiveBlocksPerMultiprocessor(&per_cu, (const void*)mk_fwd, 512, LDS_BYTES) != hipSuccess || per_cu < 1) { fprintf(stderr, "kernel_launch: occupancy query reports %d blocks per CU; nothing launched\n", per_cu); (void)hipGetLastError(); grid = -1; return; }
        grid = cus;
    }
    if (grid < 0) return;
    if (hipMemsetAsync((char*)d_ws + WS_CTL, 0, CTL_ZERO_BYTES, stream) != hipSuccess) { fprintf(stderr, "kernel_launch: memset failed\n"); return; }
    Args a{};
    for (int i = 0; i < 23; ++i) a.in[i] = (const float*)d_in[i];
    a.out = (float*)d_out; a.ws = (unsigned char*)d_ws;
#if MK_PER_STEP
    for (int s = 0; s < ST_N; ++s) { a.lo = s; a.hi = s + 1;
#if MK_DEBUG
        if (s == ST_G4 || s == ST_G6 || s == ST_G8) (void)hipMemcpyAsync((char*)d_ws + WS_HOLD, (char*)d_ws + WS_XB, (size_t)TROWS * DM * 2, hipMemcpyDeviceToDevice, stream);
#endif
        hipLaunchKernelGGL(mk_fwd, dim3(grid), dim3(512), LDS_BYTES, stream, a);
#if MK_DEBUG
        hipLaunchKernelGGL(chk_step, dim3(16), dim3(256), 0, stream, a, s, (unsigned*)d_ws + 64);
#endif
    }
#if MK_DEBUG
    hipLaunchKernelGGL(chk_final, dim3(TROWS * DM / 256), dim3(256), 0, stream, (float*)d_out, (const unsigned*)d_ws + 64);
#endif
#else
    a.lo = 0; a.hi = ST_N;
    hipLaunchKernelGGL(mk_fwd, dim3(grid), dim3(512), LDS_BYTES, stream, a);
#endif
    const hipError_t le = hipPeekAtLastError();
    if (le != hipSuccess) fprintf(stderr, "kernel_launch: launch failed: %s\n", hipGetErrorName(le));
}
```

```cpp
#include <hip/hip_runtime.h>
#include <cstdio>
#include <cstdint>

#ifndef MK_REP_MASK
#define MK_REP_MASK 0
#endif
#ifndef MK_BAR_REP
#define MK_BAR_REP 1
#endif
#ifndef MK_PROBE_AT
#define MK_PROBE_AT -1
#endif
#ifndef MK_PROBE_KIND
#define MK_PROBE_KIND 0
#endif
#ifndef MK_PROBE_MA
#define MK_PROBE_MA -1
#endif
#ifndef MK_PROBE_MB
#define MK_PROBE_MB -1
#endif
#ifndef MK_PER_STEP
#define MK_PER_STEP 0
#endif

#define LAS __attribute__((address_space(3)))
#define GAS __attribute__((address_space(1)))
typedef _Float16 f16_t;
typedef _Float16 f16x8 __attribute__((ext_vector_type(8)));
typedef _Float16 f16x2 __attribute__((ext_vector_type(2)));
typedef __fp16 fp16x4v __attribute__((__vector_size__(4 * sizeof(__fp16))));
typedef float f32x4 __attribute__((ext_vector_type(4)));
typedef unsigned u32x4 __attribute__((ext_vector_type(4)));
typedef unsigned u32x2 __attribute__((ext_vector_type(2)));

constexpr int NB = 2, SEQ = 4096, DM = 2048, TROWS = NB * SEQ;
constexpr int DFF = 5632, INC = 5120, CW = 1024, GMW = 1024, NMEM = 256, MROWS = NB * NMEM;
constexpr int XH = 4, XHD = 512;
constexpr float EPS = 1e-6f;
constexpr int NPART = 32;

__device__ __forceinline__ unsigned pk16(float a, float b) { f16x2 v = {(_Float16)a, (_Float16)b}; return __builtin_bit_cast(unsigned, v); }
__device__ __forceinline__ f16x2 as_h2(unsigned u) { const unsigned t = u; return __builtin_bit_cast(f16x2, t); }

namespace pg8 {
constexpr int BM = 256, BK = 64, HALF = 128, HTB = HALF * BK * 2  , STAGE_BYTES = 8 * HTB, NXCD = 8, WGM = 8;
__host__ __device__ __forceinline__ int lds_byte(int r, int c) { const int st = (r >> 4) * 2 + (c >> 5), rr = r & 15, cc = c & 31, ob = rr * 64 + cc * 2; return st * 1024 + (ob ^ (((ob >> 9) & 1) << 5)); }
__host__ __device__ __forceinline__ void stage_rc(int b, int& R, int& C) { const int st = b / 1024, sb = b % 1024, swz = sb ^ (((sb >> 9) & 1) << 5); R = (st >> 1) * 16 + swz / 64; C = (st & 1) * 32 + (swz % 64) / 2; }
__host__ __device__ __forceinline__ int perm32(int rho) { const int n = rho >> 4, i = rho & 15; return 8 * (i >> 2) + 4 * n + (i & 3); }

struct Unit { int pm, pn; };
struct Gemm { const f16_t* A; const f16_t* Bt; int M, N, K; int mA = -1, mB = -1; };

struct StaticOrder {
    int nM, nN, nwg, G, c;
    __device__ void init(int M, int N, int G_, int c_) { nM = M / BM; nN = N / BM; nwg = nM * nN; G = G_; c = c_; }
    __device__ bool next(int i, Unit& u) const {
        const long L = (long)i * G + c; if (L >= nwg) return false;
        int wgid = (int)L; { const int q = nwg / NXCD, r = nwg % NXCD, xcd = wgid % NXCD, off = wgid / NXCD; wgid = (xcd < r ? xcd * (q + 1) : r * (q + 1) + (xcd - r) * q) + off; }
        const int nig = WGM * nN, gid = wgid / nig, fm = gid * WGM, gsz = (nM - fm) < WGM ? (nM - fm) : WGM;
        u.pm = fm + ((wgid % nig) % gsz); u.pn = (wgid % nig) / gsz; return true;
    }
};

__device__ __forceinline__ void row_rs(const float* part, int pm, int wr, int lane, float (&rsv)[2]) {
#pragma unroll
    for (int ai = 0; ai < 2; ++ai) {
        const f32x4* p = (const f32x4*)(part + (size_t)(pm * BM + ai * HALF + wr * 64 + lane) * NPART);
        f32x4 s = p[0];
#pragma unroll
        for (int j = 1; j < NPART / 4; ++j) s += p[j];
        rsv[ai] = __builtin_amdgcn_rsqf(((s[0] + s[1]) + (s[2] + s[3])) * (1.0f / DM) + EPS);
    }
}

struct EpiF16 {
    f16_t* O; int ldc; const float* part; float scale;
    __device__ __forceinline__ void operator()(const f32x4 (&acc)[2][2][4][2], const Unit& u, int wr, int wc, int fr, int fq) const {
        const int lane = fq * 16 + fr; float rsv[2] = {1.f, 1.f};
        if (part) row_rs(part, u.pm, wr, lane, rsv);
        const int row0 = u.pm * BM + wr * 64 + fr, col0 = u.pn * BM + wc * 32 + 8 * fq;
#pragma unroll
        for (int ai = 0; ai < 2; ++ai)
#pragma unroll
            for (int m = 0; m < 4; ++m) {
                float s = scale; if (part) s *= __shfl(rsv[ai], m * 16 + fr);
                f16_t* rowp = O + (size_t)(row0 + ai * HALF + m * 16) * ldc + col0;
#pragma unroll
                for (int bj = 0; bj < 2; ++bj) { const f32x4 v0 = acc[ai][bj][m][0] * s, v1 = acc[ai][bj][m][1] * s;
                    u32x4 w; w.x = pk16(v0[0], v0[1]); w.y = pk16(v0[2], v0[3]); w.z = pk16(v1[0], v1[1]); w.w = pk16(v1[2], v1[3]);
                    *(u32x4*)(rowp + bj * HALF) = w; } }
    }
};
struct EpiSwiGLU {
    f16_t* O; const float* part;
    __device__ __forceinline__ void operator()(const f32x4 (&acc)[2][2][4][2], const Unit& u, int wr, int wc, int fr, int fq) const {
        const int lane = fq * 16 + fr; float rsv[2] = {1.f, 1.f};
        if (part) row_rs(part, u.pm, wr, lane, rsv);
        const int row0 = u.pm * BM + wr * 64 + fr, col0 = u.pn * HALF + wc * 32 + 8 * fq;
#pragma unroll
        for (int ai = 0; ai < 2; ++ai)
#pragma unroll
            for (int m = 0; m < 4; ++m) {
                float s = 1.f; if (part) s = __shfl(rsv[ai], m * 16 + fr);
                float o[8];
#pragma unroll
                for (int n = 0; n < 2; ++n)
#pragma unroll
                    for (int j = 0; j < 4; ++j) { const float g = acc[ai][0][m][n][j] * s, up = acc[ai][1][m][n][j] * s;
                        const float e = __builtin_amdgcn_exp2f(g * -1.44269504089f); o[n * 4 + j] = g * __builtin_amdgcn_rcpf(1.0f + e) * up; }
                u32x4 w; w.x = pk16(o[0], o[1]); w.y = pk16(o[2], o[3]); w.z = pk16(o[4], o[5]); w.w = pk16(o[6], o[7]);
                *(u32x4*)(O + (size_t)(row0 + ai * HALF + m * 16) * DFF + col0) = w; }
    }
};
struct EpiRes {
    const float* base32; const f16_t* base16; f16_t* HH; float* part; float alpha;
    __device__ __forceinline__ void operator()(const f32x4 (&acc)[2][2][4][2], const Unit& u, int wr, int wc, int fr, int fq) const {
        const int row0 = u.pm * BM + wr * 64 + fr, col0 = u.pn * BM + wc * 32 + 8 * fq;
#pragma unroll
        for (int ai = 0; ai < 2; ++ai)
#pragma unroll
            for (int m = 0; m < 4; ++m) {
                const int row = row0 + ai * HALF + m * 16; const size_t off = (size_t)row * DM + col0; float ss = 0.f;
#pragma unroll
                for (int bj = 0; bj < 2; ++bj) {
                    f32x4 b0, b1;
                    if (base32) { b0 = *(const GAS f32x4*)(base32 + off + bj * HALF); b1 = *(const GAS f32x4*)(base32 + off + bj * HALF + 4); }
                    else { const u32x4 bw = *(const u32x4*)(base16 + off + bj * HALF); const f16x2 p0 = as_h2(bw.x), p1 = as_h2(bw.y), p2 = as_h2(bw.z), p3 = as_h2(bw.w);
                        b0 = (f32x4){(float)p0[0], (float)p0[1], (float)p1[0], (float)p1[1]}; b1 = (f32x4){(float)p2[0], (float)p2[1], (float)p3[0], (float)p3[1]}; }
                    const f32x4 h0 = b0 + acc[ai][bj][m][0] * alpha, h1 = b1 + acc[ai][bj][m][1] * alpha;
                    ss += (h0[0] * h0[0] + h0[1] * h0[1]) + (h0[2] * h0[2] + h0[3] * h0[3]) + (h1[0] * h1[0] + h1[1] * h1[1]) + (h1[2] * h1[2] + h1[3] * h1[3]);
                    u32x4 w; w.x = pk16(h0[0], h0[1]); w.y = pk16(h0[2], h0[3]); w.z = pk16(h1[0], h1[1]); w.w = pk16(h1[2], h1[3]);
                    *(u32x4*)(HH + off + bj * HALF) = w; }
                ss += __shfl_xor(ss, 16); ss += __shfl_xor(ss, 32);
                if (part && fq == 0) part[(size_t)row * NPART + u.pn * 4 + wc] = ss; }
    }
};

template <class Epi>
__device__ __forceinline__ void gemm_phase(LAS unsigned char* lds, const Gemm g, const StaticOrder& S, const Epi& E) {
    int tid_ = threadIdx.x; asm volatile("" : "+v"(tid_));
    const int tid = tid_, wid = __builtin_amdgcn_readfirstlane(tid >> 6), lane = tid & 63, wr = wid >> 2, wc = wid & 3, fr = lane & 15, fq = lane >> 4;
    const int K = g.K, nt = K / BK;
    unsigned voffA[2], voffB[2];
#pragma unroll
    for (int i = 0; i < 2; ++i) { int R, C; stage_rc(tid * 16 + i * 8192, R, C); const int Rb = (R & ~31) + perm32(R & 31);
        voffA[i] = (unsigned)(R * K + C) * 2u; voffB[i] = (unsigned)(Rb * K + C) * 2u; }
    const size_t kstep = (size_t)(BK * 2);
    const size_t hstep = (size_t)HALF * K * 2;
    const size_t tstep = 2 * hstep;
    const unsigned ldsw = (unsigned)wid * 1024u;
    const int aoff = lds_byte(wr * 64 + fr, fq * 8), boff = lds_byte(wc * 32 + fr, fq * 8);
#define PG8_SA(b, h) (((b) * 2 + (h)) * HTB)
#define PG8_SB(b, h) ((4 + (b) * 2 + (h)) * HTB)
#define PG8_STAGE(bufoff, gbase, voff) do { _Pragma("unroll") for (int _i = 0; _i < 2; ++_i) \
        __builtin_amdgcn_global_load_lds((const unsigned*)((const char*)(gbase) + (voff)[_i]), (LAS unsigned*)(lds + (bufoff) + ldsw + _i * 8192), 16, 0, 0); } while (0)
#define PG8_LDA(dst, b, h) do { _Pragma("unroll") for (int m = 0; m < 4; ++m) _Pragma("unroll") for (int k = 0; k < 2; ++k) dst[m][k] = *(const LAS f16x8*)(lds + PG8_SA(b, h) + aoff + m * 2048 + k * 1024); } while (0)
#define PG8_LDB(dst, b, h) do { _Pragma("unroll") for (int n = 0; n < 2; ++n) _Pragma("unroll") for (int k = 0; k < 2; ++k) dst[n][k] = *(const LAS f16x8*)(lds + PG8_SB(b, h) + boff + n * 2048 + k * 1024); } while (0)
#define PG8_MMA(ai, bj, At, Bt) do { __builtin_amdgcn_s_setprio(1); _Pragma("unroll") for (int m = 0; m < 4; ++m) _Pragma("unroll") for (int n = 0; n < 2; ++n) _Pragma("unroll") for (int k = 0; k < 2; ++k) \
        acc[ai][bj][m][n] = __builtin_amdgcn_mfma_f32_16x16x32_f16(Bt[n][k], At[m][k], acc[ai][bj][m][n], 0, 0, 0); __builtin_amdgcn_s_setprio(0); } while (0)
#define PG8_WAIT_V(n) asm volatile("s_waitcnt vmcnt(" #n ")" ::: "memory")
#define PG8_WAIT_L(n) asm volatile("s_waitcnt lgkmcnt(" #n ")" ::: "memory")
#define PG8_BAR __builtin_amdgcn_s_barrier()
#define PG8_SCHED __builtin_amdgcn_sched_barrier(0)
    Unit cur, nxt; int ui = 0;
    if (!S.next(0, cur)) return;
    f32x4 acc[2][2][4][2];
#pragma unroll
    for (int a = 0; a < 2; ++a)
#pragma unroll
        for (int b = 0; b < 2; ++b)
#pragma unroll
            for (int m = 0; m < 4; ++m)
#pragma unroll
                for (int n = 0; n < 2; ++n) acc[a][b][m][n] = (f32x4){0.f, 0.f, 0.f, 0.f};
    f16x8 At[4][2], B0[2][2], B1[2][2];
    const char* cA = (const char*)g.A + (size_t)(cur.pm & g.mA) * tstep; const char* cB = (const char*)g.Bt + (size_t)(cur.pn & g.mB) * tstep;
    PG8_STAGE(PG8_SB(0, 0), cB, voffB); PG8_STAGE(PG8_SB(0, 1), cB + hstep, voffB); PG8_STAGE(PG8_SA(0, 0), cA, voffA); PG8_STAGE(PG8_SA(0, 1), cA + hstep, voffA);
    if (wr == 1) PG8_BAR;
    PG8_WAIT_V(2); PG8_BAR;
    PG8_STAGE(PG8_SB(1, 0), cB + kstep, voffB); PG8_STAGE(PG8_SA(1, 0), cA + kstep, voffA); PG8_STAGE(PG8_SB(1, 1), cB + hstep + kstep, voffB);
    PG8_WAIT_V(6); PG8_BAR;
    for (;;) {
        const bool has_next = S.next(ui + 1, nxt);
        const char* nA = has_next ? (const char*)g.A + (size_t)(nxt.pm & g.mA) * tstep : cA; const char* nB = has_next ? (const char*)g.Bt + (size_t)(nxt.pn & g.mB) * tstep : cB;
        for (int t = 0; t < nt; t += 2) {
            const bool last = (t == nt - 2);
            const char* a1 = cA + (size_t)(t + 1) * kstep;
            const char* a2 = last ? nA : cA + (size_t)(t + 2) * kstep; const char* b2 = last ? nB : cB + (size_t)(t + 2) * kstep;
            const char* a3 = a2 + kstep; const char* b3 = b2 + kstep;
            PG8_LDB(B0, 0, 0); PG8_LDB(B1, 0, 1); PG8_SCHED; PG8_LDA(At, 0, 0); PG8_STAGE(PG8_SA(1, 1), a1 + hstep, voffA);
            PG8_WAIT_V(8); PG8_WAIT_L(0); PG8_BAR; PG8_MMA(0, 0, At, B0); PG8_MMA(0, 1, At, B1); PG8_BAR; PG8_SCHED;
            PG8_LDA(At, 0, 1); PG8_STAGE(PG8_SB(0, 0), b2, voffB); PG8_STAGE(PG8_SB(0, 1), b2 + hstep, voffB); PG8_STAGE(PG8_SA(0, 0), a2, voffA);
            PG8_WAIT_V(8); PG8_WAIT_L(0); PG8_BAR; PG8_MMA(1, 0, At, B0); PG8_MMA(1, 1, At, B1); PG8_BAR; PG8_SCHED;
            PG8_LDB(B0, 1, 0); PG8_LDB(B1, 1, 1); PG8_SCHED; PG8_LDA(At, 1, 0); PG8_STAGE(PG8_SA(0, 1), a2 + hstep, voffA);
            PG8_WAIT_V(8); PG8_WAIT_L(0); PG8_BAR; PG8_MMA(0, 0, At, B0); PG8_MMA(0, 1, At, B1); PG8_BAR; PG8_SCHED;
            PG8_LDA(At, 1, 1); PG8_STAGE(PG8_SB(1, 0), b3, voffB); PG8_STAGE(PG8_SB(1, 1), b3 + hstep, voffB); PG8_STAGE(PG8_SA(1, 0), a3, voffA);
            PG8_WAIT_V(8); PG8_WAIT_L(0); PG8_BAR; PG8_MMA(1, 0, At, B0); PG8_MMA(1, 1, At, B1); PG8_BAR; PG8_SCHED;
        }
        if (wr == 0) PG8_BAR;
        E(acc, cur, wr, wc, fr, fq);
        if (!has_next) break;
#pragma unroll
        for (int a = 0; a < 2; ++a)
#pragma unroll
            for (int b = 0; b < 2; ++b)
#pragma unroll
                for (int m = 0; m < 4; ++m)
#pragma unroll
                    for (int n = 0; n < 2; ++n) acc[a][b][m][n] = (f32x4){0.f, 0.f, 0.f, 0.f};
        cur = nxt; cA = nA; cB = nB; ++ui;
        if (wr == 1) PG8_BAR;
    }
    PG8_WAIT_V(0);
    PG8_BAR;
#undef PG8_SA
#undef PG8_SB
#undef PG8_STAGE
#undef PG8_LDA
#undef PG8_LDB
#undef PG8_MMA
#undef PG8_WAIT_V
#undef PG8_WAIT_L
#undef PG8_BAR
#undef PG8_SCHED
}
}

constexpr size_t MiB = 1u << 20;
constexpr size_t WS_CTL = 0, CTL_ZERO_BYTES = 64 * 1024;
constexpr size_t WS_PART1 = 1 * MiB, WS_PART2 = 2 * MiB, WS_PART3 = 3 * MiB;
constexpr size_t WS_WSP = 4 * MiB;
constexpr size_t WS_MEMN = 5 * MiB;
constexpr size_t WS_KV = 7 * MiB;
constexpr size_t WS_W1IN = 12 * MiB, WS_W1OUT = 56 * MiB, WS_WMIXIN = 78 * MiB, WS_WMIXOUT = 98 * MiB, WS_WQ = 106 * MiB, WS_WKV = 114 * MiB,
                 WS_WO = 130 * MiB, WS_W2IN = 138 * MiB, WS_W2OUT = 182 * MiB;
constexpr size_t WS_XA = 204 * MiB, WS_XB = 236 * MiB;
constexpr size_t WS_ACT = 268 * MiB;
constexpr size_t WS_END = 356 * MiB;
constexpr int CW_BAR = 4096;

constexpr int RING_BYTES = 131072;
constexpr int PREP_SCR = 64 * 65 * 4;
constexpr int MISC_OFF = 8 * PREP_SCR;
constexpr int LDS_BYTES = 147456;

#define XB_TMO      128
#define XB_XCNT(j)  (256  + 64 * (j))
#define XB_XSUB(j)  (1280 + 64 * (j))
#define XB_XGEN(j)  (2304 + 64 * (j))
#define XB_TOP      3328
#define XB_TOPGEN   3392
#define XCD_BAR_WORDS 3456
#define XB_SPIN_CAP (1u << 20)
__device__ __forceinline__ unsigned xb_ld(unsigned* p)              { return __hip_atomic_load(p, __ATOMIC_RELAXED, __HIP_MEMORY_SCOPE_AGENT); }
__device__ __forceinline__ unsigned xb_add(unsigned* p, unsigned v) { return __hip_atomic_fetch_add(p, v, __ATOMIC_RELAXED, __HIP_MEMORY_SCOPE_AGENT); }
__device__ __forceinline__ unsigned xb_xcc_id() { return (unsigned)__builtin_amdgcn_s_getreg((3 << 11) | 20) & 0xFu; }
#define XB_SPIN(cond, bar) do { unsigned _sp = 0; while (cond) { __builtin_amdgcn_s_sleep(1); \
    if ((++_sp & 255u) == 0u) { if (xb_ld(&(bar)[XB_TMO])) break; if (_sp > XB_SPIN_CAP) { atomicAdd(&(bar)[XB_TMO], 1u); break; } } } } while (0)
struct XcdBarrier { unsigned* bar; unsigned x; volatile LAS unsigned* st; };
__device__ __forceinline__ XcdBarrier xcd_barrier_post(unsigned* bar, volatile LAS unsigned* st) {
    XcdBarrier b; b.bar = bar; b.x = xb_xcc_id(); b.st = st;
    if (threadIdx.x == 0) (void)xb_add(&bar[XB_XCNT(b.x)], 1u);
    return b;
}
__device__ __forceinline__ void xcd_barrier_complete(unsigned* bar, unsigned x, unsigned& nloc, unsigned& nx) {
    const unsigned G = gridDim.x * gridDim.y * gridDim.z;
    unsigned sum, cnt, mine, sp = 0u;
    for (;;) {
        sum = 0u; cnt = 0u; mine = 0u;
#pragma unroll
        for (unsigned j = 0; j < 16; ++j) { const unsigned c = xb_ld(&bar[XB_XCNT(j)]); sum += c; cnt += (c > 0u) ? 1u : 0u; mine = (j == x) ? c : mine; }
        if (sum == G) break;
        __builtin_amdgcn_s_sleep(1);
        if ((++sp & 255u) == 0u) { if (xb_ld(&bar[XB_TMO])) break; if (sp > XB_SPIN_CAP) { atomicAdd(&bar[XB_TMO], 1u); break; } }
    }
    nloc = mine > 0u ? mine : 1u; nx = cnt > 0u ? cnt : 1u;
}
__device__ __forceinline__ void xcd_barrier(const XcdBarrier& b) {
    asm volatile("s_waitcnt vmcnt(0)" ::: "memory");
    __syncthreads();
    if (threadIdx.x == 0) {
        unsigned* bar = b.bar;
        __builtin_amdgcn_s_waitcnt(0);
        unsigned nloc = b.st[0], nx = b.st[1];
        if (nloc == 0u) { xcd_barrier_complete(bar, b.x, nloc, nx); b.st[0] = nloc; b.st[1] = nx; }
        const unsigned old = xb_add(&bar[XB_XSUB(b.x)], 1u);
        const unsigned gen = old / nloc;
        if (old + 1u == (gen + 1u) * nloc) {
            __builtin_amdgcn_fence(__ATOMIC_RELEASE, "agent");
            asm volatile("s_waitcnt vmcnt(0)" ::: "memory");
            const unsigned og = xb_add(&bar[XB_TOP], 1u);
            const unsigned tg = og / nx;
            if (og + 1u == (tg + 1u) * nx) xb_add(&bar[XB_TOPGEN], 1u);
            else XB_SPIN(xb_ld(&bar[XB_TOPGEN]) == tg, bar);
            __builtin_amdgcn_fence(__ATOMIC_ACQUIRE, "agent");
            xb_add(&bar[XB_XGEN(b.x)], 1u);
            asm volatile("s_waitcnt vmcnt(0)" ::: "memory");
        } else {
            XB_SPIN(xb_ld(&bar[XB_XGEN(b.x)]) == gen, bar);
            __builtin_amdgcn_fence(__ATOMIC_ACQUIRE, "agent");
            asm volatile("s_waitcnt vmcnt(0)" ::: "memory");
        }
    }
    __syncthreads();
}

#define LDS_WAIT() asm volatile("s_waitcnt lgkmcnt(0)" ::: "memory")
__device__ __forceinline__ float wave_sum(float v) {
#pragma unroll
    for (int o = 1; o < 64; o <<= 1) v += __shfl_xor(v, o);
    return v;
}
struct TItem { const float* src; f16_t* dst; const float* gk; int N, K; };
__device__ __forceinline__ void t_load(const TItem& t, f32x4 (&v)[16], int lane) {
    const float* s = t.src + (size_t)(lane >> 4) * t.N + 4 * (lane & 15);
#pragma unroll
    for (int i = 0; i < 16; ++i) v[i] = __builtin_nontemporal_load((const GAS f32x4*)(s + (size_t)(4 * i) * t.N));
}
__device__ __forceinline__ void t_to_lds(const TItem& t, f32x4 (&v)[16], LAS float* scr, int lane) {
    const int n4 = lane & 15, kq = lane >> 4;
    if (t.gk) {
#pragma unroll
        for (int i = 0; i < 16; ++i) v[i] *= *(const GAS float*)(t.gk + 4 * i + kq); }
#pragma unroll
    for (int i = 0; i < 16; ++i) { LAS float* d = scr + (4 * i + kq) * 65 + 4 * n4; d[0] = v[i][0]; d[1] = v[i][1]; d[2] = v[i][2]; d[3] = v[i][3]; }
}
__device__ __forceinline__ void t_store(const TItem& t, LAS float* scr, int lane) {
    const int c = lane & 7;
#pragma unroll
    for (int j = 0; j < 8; ++j) { const int n = (lane >> 3) + 8 * j; const LAS float* s = scr + (8 * c) * 65 + n;
        u32x4 o; o.x = pk16(s[0 * 65], s[1 * 65]); o.y = pk16(s[2 * 65], s[3 * 65]); o.z = pk16(s[4 * 65], s[5 * 65]); o.w = pk16(s[6 * 65], s[7 * 65]);
        *(u32x4*)(t.dst + (size_t)n * t.K + 8 * c) = o; }
}
__device__ __forceinline__ TItem prep_item(const float* W, int K, int N, f16_t* WT, int row_off, bool ileave, const float* gk, int r) {
    const int nblk = N / 64, kb = r / nblk, nb = r - kb * nblk, n0 = 64 * nb, k0 = 64 * kb;
    int dr;
    if (ileave) { const int half = N / 2, up = n0 >= half ? 1 : 0, nn = n0 - up * half; dr = (nn >> 7) * 256 + up * 128 + (nn & 127); } else dr = row_off + n0;
    TItem t; t.src = W + (size_t)k0 * N + n0; t.dst = WT + (size_t)dr * K + k0; t.gk = gk ? gk + k0 : nullptr; t.N = N; t.K = K; return t;
}
__device__ __forceinline__ void norm_row_f16(const float* xrow, const float* g, f16_t* orow, int lane) {
    const GAS f32x4* xr = (const GAS f32x4*)xrow + lane; const GAS f32x4* gr = (const GAS f32x4*)g + lane;
    f32x4 v[8]; float s = 0.f;
#pragma unroll
    for (int j = 0; j < 8; ++j) { v[j] = xr[64 * j]; s += (v[j][0] * v[j][0] + v[j][1] * v[j][1]) + (v[j][2] * v[j][2] + v[j][3] * v[j][3]); }
    const float rs = __builtin_amdgcn_rsqf(wave_sum(s) * (1.f / DM) + EPS);
    u32x2* o8 = (u32x2*)orow + lane;
#pragma unroll
    for (int j = 0; j < 8; ++j) { const f32x4 gg = gr[64 * j]; u32x2 w; w.x = pk16(v[j][0] * rs * gg[0], v[j][1] * rs * gg[1]); w.y = pk16(v[j][2] * rs * gg[2], v[j][3] * rs * gg[3]); o8[64 * j] = w; }
}

struct Args { const float* in[23]; float* out; unsigned char* ws; int lo, hi; };
__device__ __forceinline__ const float* inp(int i) {
    const __attribute__((address_space(4))) unsigned long long* t = (const __attribute__((address_space(4))) unsigned long long*)__builtin_amdgcn_kernarg_segment_ptr();
    asm volatile("" : "+s"(i));
    return (const float*)t[i];
}
enum { I_X = 0, I_MEM, I_GFFN1, I_W1IN, I_W1OUT, I_GMIX, I_WMIXIN, I_CONVW, I_CONVB, I_GGMV, I_WSP, I_BSP, I_WMIXOUT, I_GXATTN, I_GMEM, I_WQ, I_WK, I_WV, I_WO, I_GFFN2, I_W2IN, I_W2OUT, I_GFINAL };
enum { ST_PREP = 0, ST_G1, ST_G2, ST_G3, ST_KV, ST_MIX, ST_G4, ST_G5, ST_ATT, ST_G6, ST_G7, ST_G8, ST_FIN, ST_N };

__device__ __forceinline__ TItem conv_item(const Args& a, int set, int it) {
    unsigned char* ws = a.ws;
    constexpr int I_FIN = (DM / 64) * (2 * DFF / 64), I_FOUT = (DFF / 64) * (DM / 64), I_MIXIN = (DM / 64) * (INC / 64), I_SQ = (DM / 64) * (DM / 64);
    int r = it;
    if (set == 0) {
        if (r < I_FIN) return prep_item(inp(I_W1IN), DM, 2 * DFF, (f16_t*)(ws + WS_W1IN), 0, true, nullptr, r); r -= I_FIN;
        return prep_item(inp(I_W1OUT), DFF, DM, (f16_t*)(ws + WS_W1OUT), 0, false, nullptr, r);
    } else if (set == 1) {
        if (r < I_MIXIN) return prep_item(inp(I_WMIXIN), DM, INC, (f16_t*)(ws + WS_WMIXIN), 0, false, inp(I_GMIX), r); r -= I_MIXIN;
        if (r < I_SQ) return prep_item(inp(I_WK), DM, DM, (f16_t*)(ws + WS_WKV), 0, false, nullptr, r); r -= I_SQ;
        if (r < I_SQ) return prep_item(inp(I_WV), DM, DM, (f16_t*)(ws + WS_WKV), DM, false, nullptr, r); r -= I_SQ;
        if (r < I_SQ) return prep_item(inp(I_WMIXOUT), DM, DM, (f16_t*)(ws + WS_WMIXOUT), 0, false, nullptr, r); r -= I_SQ;
        if (r < I_SQ) return prep_item(inp(I_WQ), DM, DM, (f16_t*)(ws + WS_WQ), 0, false, inp(I_GXATTN), r); r -= I_SQ;
        return prep_item(inp(I_WO), DM, DM, (f16_t*)(ws + WS_WO), 0, false, nullptr, r);
    } else if (set == 2) return prep_item(inp(I_W2IN), DM, 2 * DFF, (f16_t*)(ws + WS_W2IN), 0, true, inp(I_GFFN2), r);
    return prep_item(inp(I_W2OUT), DFF, DM, (f16_t*)(ws + WS_W2OUT), 0, false, nullptr, r);
}
__device__ __forceinline__ void conv_set(const Args& a, LAS unsigned char* lds, int set, int gw, int NGW, int wave, int lane) {
    LAS float* scr = (LAS float*)(lds + wave * PREP_SCR);
    constexpr int I_FIN = (DM / 64) * (2 * DFF / 64), I_FOUT = (DFF / 64) * (DM / 64), I_MIXIN = (DM / 64) * (INC / 64), I_SQ = (DM / 64) * (DM / 64);
    const int n = set == 0 ? I_FIN + I_FOUT : set == 1 ? I_MIXIN + 5 * I_SQ : set == 2 ? I_FIN : I_FOUT;
    int it = gw; if (it >= n) return;
    f32x4 v[16]; TItem cur = conv_item(a, set, it); t_load(cur, v, lane);
    for (;;) {
        t_to_lds(cur, v, scr, lane);
        const int nit = it + NGW; TItem nxt = cur;
        if (nit < n) { nxt = conv_item(a, set, nit); t_load(nxt, v, lane); }
        LDS_WAIT(); asm volatile("" ::: "memory");
        t_store(cur, scr, lane);
        LDS_WAIT(); asm volatile("" ::: "memory");
        if (nit >= n) break;
        it = nit; cur = nxt;
    }
}
__device__ __forceinline__ void step_prep(const Args& a, LAS unsigned char* lds, int G, int vcu, int tid, int wave, int lane) {
    unsigned char* ws = a.ws;
    const int gw = vcu * 8 + wave, NGW = G * 8;
    conv_set(a, lds, 0, gw, NGW, wave, lane);
    for (int m = gw; m < TROWS; m += NGW) norm_row_f16(inp(I_X) + (size_t)m * DM, inp(I_GFFN1), (f16_t*)(ws + WS_XA) + (size_t)m * DM, lane);
    for (int m = gw; m < MROWS; m += NGW) norm_row_f16(inp(I_MEM) + (size_t)m * DM, inp(I_GMEM), (f16_t*)(ws + WS_MEMN) + (size_t)m * DM, lane);
    { const GAS f32x4* src = (const GAS f32x4*)inp(I_WSP); u32x2* dst = (u32x2*)(ws + WS_WSP);
      for (int i = vcu * 512 + tid; i < 8 * 128 * 128 / 4; i += G * 512) { const int t = (i >> 5) & 127, s0 = (i & 31) * 4; const f32x4 v = src[i];
          u32x2 w; w.x = pk16(s0 <= t ? v[0] : 0.f, s0 + 1 <= t ? v[1] : 0.f); w.y = pk16(s0 + 2 <= t ? v[2] : 0.f, s0 + 3 <= t ? v[3] : 0.f); dst[i] = w; } }
}

__device__ __forceinline__ void f16x8_to_f32(const u32x4 w, float (&f)[8]) {
#pragma unroll
    for (int j = 0; j < 4; ++j) { const f16x2 h = as_h2(w[j]); f[2 * j] = (float)h[0]; f[2 * j + 1] = (float)h[1]; }
}
__device__ __forceinline__ void conv_unit(const Args& a, int cu, int tid) {
    const f16_t* Z = (const f16_t*)(a.ws + WS_ACT); f16_t* Y = (f16_t*)(a.ws + WS_XA);
    const int cg = tid & 127, rg = tid >> 7, c = 8 * cg, r0 = 32 * cu + 8 * rg;
    float w0[8], w1[8], w2[8], cb[8];
    { const GAS f32x4* p = (const GAS f32x4*)(inp(I_CONVW) + c); const f32x4 a0 = p[0], a1 = p[1], b0 = p[CW / 4], b1 = p[CW / 4 + 1], c0 = p[2 * CW / 4], c1 = p[2 * CW / 4 + 1];
      const GAS f32x4* q = (const GAS f32x4*)(inp(I_CONVB) + c); const f32x4 d0 = q[0], d1 = q[1];
#pragma unroll
      for (int j = 0; j < 4; ++j) { w0[j] = a0[j]; w0[4 + j] = a1[j]; w1[j] = b0[j]; w1[4 + j] = b1[j]; w2[j] = c0[j]; w2[4 + j] = c1[j]; cb[j] = d0[j]; cb[4 + j] = d1[j]; } }
    float m2[8], m1[8];
    const bool first = (r0 & (SEQ - 1)) == 0;
    {
        float x[8], y[8];
        if (!first) {
            f16x8_to_f32(*(const u32x4*)(Z + (size_t)(r0 - 2) * INC + CW + c), x); f16x8_to_f32(*(const u32x4*)(Z + (size_t)(r0 - 2) * INC + 2 * CW + c), y);
#pragma unroll
            for (int j = 0; j < 8; ++j) m2[j] = x[j] * y[j];
            f16x8_to_f32(*(const u32x4*)(Z + (size_t)(r0 - 1) * INC + CW + c), x); f16x8_to_f32(*(const u32x4*)(Z + (size_t)(r0 - 1) * INC + 2 * CW + c), y);
#pragma unroll
            for (int j = 0; j < 8; ++j) m1[j] = x[j] * y[j];
        } else {
#pragma unroll
            for (int j = 0; j < 8; ++j) { m2[j] = 0.f; m1[j] = 0.f; }
        }
    }
#pragma unroll
    for (int rr = 0; rr < 8; ++rr) {
        const size_t ro = (size_t)(r0 + rr) * INC + c;
        float gb[8], gc[8], hc[8], o[8];
        f16x8_to_f32(*(const u32x4*)(Z + ro), gb); f16x8_to_f32(*(const u32x4*)(Z + ro + CW), gc); f16x8_to_f32(*(const u32x4*)(Z + ro + 2 * CW), hc);
#pragma unroll
        for (int j = 0; j < 8; ++j) { const float ch = gc[j] * hc[j]; o[j] = gb[j] * (cb[j] + w2[j] * ch + w1[j] * m1[j] + w0[j] * m2[j]); m2[j] = m1[j]; m1[j] = ch; }
        u32x4 w; w.x = pk16(o[0], o[1]); w.y = pk16(o[2], o[3]); w.z = pk16(o[4], o[5]); w.w = pk16(o[6], o[7]);
        *(u32x4*)(Y + (size_t)(r0 + rr) * DM + c) = w;
    }
}
constexpr int VNT_PITCH = 272;
__device__ __forceinline__ void gm_unit(const Args& a, LAS unsigned char* lds, int gu, int tid, int wave, int lane) {
    const f16_t* Z = (const f16_t*)(a.ws + WS_ACT); f16_t* Y = (f16_t*)(a.ws + WS_XA); const f16_t* WSP = (const f16_t*)(a.ws + WS_WSP);
    const int head = gu & 7, R0 = (gu >> 3) * 128;
    { const int ch = tid & 15, sr = tid >> 4; float gg[8];
      { const GAS f32x4* p = (const GAS f32x4*)(inp(I_GGMV) + head * 128 + 8 * ch); const f32x4 g0 = p[0], g1 = p[1];
#pragma unroll
        for (int j = 0; j < 4; ++j) { gg[j] = g0[j]; gg[4 + j] = g1[j]; } }
#pragma unroll
      for (int ps = 0; ps < 4; ++ps) { const int s = sr + 32 * ps; float v[8];
          f16x8_to_f32(*(const u32x4*)(Z + (size_t)(R0 + s) * INC + 4 * CW + head * 128 + 8 * ch), v);
          float ss = 0.f;
#pragma unroll
          for (int j = 0; j < 8; ++j) ss += v[j] * v[j];
          ss += __shfl_xor(ss, 1); ss += __shfl_xor(ss, 2); ss += __shfl_xor(ss, 4); ss += __shfl_xor(ss, 8);
          const float rs = __builtin_amdgcn_rsqf(ss * (1.f / 128.f) + EPS);
#pragma unroll
          for (int j = 0; j < 8; ++j) *(LAS f16_t*)(lds + (8 * ch + j) * VNT_PITCH + 2 * s) = (f16_t)(v[j] * rs * gg[j]); } }
    __syncthreads();
    const int fr = lane & 15, g = lane >> 4;
    f16x8 Af[4];
#pragma unroll
    for (int ks = 0; ks < 4; ++ks) Af[ks] = *(const LAS f16x8*)(lds + (16 * wave + fr) * VNT_PITCH + (32 * ks + 8 * g) * 2);
    f32x4 acc[8];
    const f16_t* wrow = WSP + (size_t)head * 128 * 128 + (size_t)fr * 128 + 8 * g;
#pragma unroll
    for (int tb = 0; tb < 8; ++tb) { acc[tb] = (f32x4){0.f, 0.f, 0.f, 0.f};
#pragma unroll
        for (int ks = 0; ks < 4; ++ks) if (32 * ks <= 16 * tb + 15) { const f16x8 Bf = *(const f16x8*)(wrow + (size_t)tb * 16 * 128 + 32 * ks);
            acc[tb] = __builtin_amdgcn_mfma_f32_16x16x32_f16(Af[ks], Bf, acc[tb], 0, 0, 0); } }
#pragma unroll
    for (int tb = 0; tb < 8; ++tb) { const int t = 16 * tb + fr; const float bs = *(const GAS float*)(inp(I_BSP) + head * 128 + t);
        const size_t ro = (size_t)(R0 + t); const int cc = head * 128 + 16 * wave + 4 * g;
        const u32x2 uw = *(const u32x2*)(Z + ro * INC + 3 * CW + cc); const f16x2 u0 = as_h2(uw.x), u1 = as_h2(uw.y);
        u32x2 w; w.x = pk16((float)u0[0] * (acc[tb][0] + bs), (float)u0[1] * (acc[tb][1] + bs)); w.y = pk16((float)u1[0] * (acc[tb][2] + bs), (float)u1[1] * (acc[tb][3] + bs));
        *(u32x2*)(Y + ro * DM + CW + cc) = w; }
    __syncthreads();
}

__device__ __forceinline__ void attn_unit(const Args& a, LAS unsigned char* lds, int b, int h, int qb, int tid, int wave, int lane) {
    const f16_t* Q = (const f16_t*)(a.ws + WS_XA); const f16_t* KV = (const f16_t*)(a.ws + WS_KV); f16_t* O = (f16_t*)(a.ws + WS_ACT);
    const int fr = lane & 15, g = lane >> 4;
    const int R0 = b * SEQ + qb * 128 + wave * 16;
    f16x8 Qf[16];
    { const f16_t* qp = Q + (size_t)(R0 + fr) * DM + h * XHD + 8 * g;
#pragma unroll
      for (int kk = 0; kk < 16; ++kk) Qf[kk] = *(const f16x8*)(qp + 32 * kk); }
    const int srow = tid >> 3, sc = tid & 7;
    const f16_t* kbase = KV + (size_t)(b * NMEM + srow) * (2 * DM) + h * XHD + sc * 8;
    const unsigned swoff = (unsigned)(srow * 128 + ((sc ^ (srow & 7)) << 4));
    u32x4 st[4];
#define AT_LOAD(c) do { const f16_t* _p = kbase + ((c) >= 8 ? DM : 0) + 64 * ((c) & 7); _Pragma("unroll") for (int _i = 0; _i < 4; ++_i) st[_i] = *(const u32x4*)(_p + (size_t)_i * 64 * (2 * DM)); } while (0)
#define AT_WRITE(buf) do { _Pragma("unroll") for (int _i = 0; _i < 4; ++_i) *(LAS u32x4*)(lds + (buf) * 32768 + swoff + _i * 8192) = st[_i]; } while (0)
    AT_LOAD(0); AT_WRITE(0); __syncthreads();
    f32x4 S[16];
#pragma unroll
    for (int i = 0; i < 16; ++i) S[i] = (f32x4){0.f, 0.f, 0.f, 0.f};
    unsigned aoffK[2];
#pragma unroll
    for (int ks = 0; ks < 2; ++ks) aoffK[ks] = (unsigned)(fr * 128 + (((4 * ks + g) ^ (fr & 7)) << 4));
#pragma unroll
    for (int dc = 0; dc < 8; ++dc) {
        AT_LOAD(dc + 1);
        const LAS unsigned char* bp = lds + (dc & 1) * 32768;
#pragma unroll
        for (int mt = 0; mt < 16; ++mt)
#pragma unroll
            for (int ks = 0; ks < 2; ++ks) S[mt] = __builtin_amdgcn_mfma_f32_16x16x32_f16(*(const LAS f16x8*)(bp + mt * 2048 + aoffK[ks]), Qf[2 * dc + ks], S[mt], 0, 0, 0);
        AT_WRITE((dc + 1) & 1); __syncthreads();
    }
    float mx = S[0][0];
#pragma unroll
    for (int i = 0; i < 16; ++i) mx = fmaxf(fmaxf(mx, fmaxf(S[i][0], S[i][1])), fmaxf(S[i][2], S[i][3]));
    mx = fmaxf(mx, __shfl_xor(mx, 16)); mx = fmaxf(mx, __shfl_xor(mx, 32));
    float l = 0.f;
#pragma unroll
    for (int i = 0; i < 16; ++i)
#pragma unroll
        for (int r = 0; r < 4; ++r) { const float p = __builtin_amdgcn_exp2f(S[i][r] - mx); S[i][r] = p; l += p; }
    l += __shfl_xor(l, 16); l += __shfl_xor(l, 32);
    const float inv_l = 1.0f / l;
    f16x8 Pf[8];
#pragma unroll
    for (int ks = 0; ks < 8; ++ks) { u32x4 w; w.x = pk16(S[2 * ks][0], S[2 * ks][1]); w.y = pk16(S[2 * ks][2], S[2 * ks][3]); w.z = pk16(S[2 * ks + 1][0], S[2 * ks + 1][1]); w.w = pk16(S[2 * ks + 1][2], S[2 * ks + 1][3]);
        Pf[ks] = __builtin_bit_cast(f16x8, w); }
    const int q4 = fr >> 2, p4 = fr & 3;
    unsigned voff[4];
#pragma unroll
    for (int dt = 0; dt < 4; ++dt) voff[dt] = (unsigned)((4 * g + q4) * 128 + (((2 * dt + (p4 >> 1)) ^ (((g & 1) << 2) + q4)) << 4) + (p4 & 1) * 8);
    f16_t* orow = O + (size_t)(R0 + fr) * DM + h * XHD + 4 * g;
    for (int dc = 0; dc < 8; ++dc) {
        if (dc < 7) AT_LOAD(dc + 9);
        const LAS unsigned char* bp = lds + (dc & 1) * 32768;
#pragma unroll
        for (int dt = 0; dt < 4; ++dt) { f32x4 o = (f32x4){0.f, 0.f, 0.f, 0.f};
#pragma unroll
            for (int ks = 0; ks < 8; ++ks) {
                const fp16x4v t1 = __builtin_amdgcn_ds_read_tr16_b64_v4f16((LAS fp16x4v*)(bp + ks * 4096 + voff[dt]));
                const fp16x4v t2 = __builtin_amdgcn_ds_read_tr16_b64_v4f16((LAS fp16x4v*)(bp + ks * 4096 + 2048 + voff[dt]));
                const u32x2 w1 = __builtin_bit_cast(u32x2, t1), w2 = __builtin_bit_cast(u32x2, t2); const u32x4 w = {w1.x, w1.y, w2.x, w2.y};
                o = __builtin_amdgcn_mfma_f32_16x16x32_f16(__builtin_bit_cast(f16x8, w), Pf[ks], o, 0, 0, 0); }
            u32x2 w; w.x = pk16(o[0] * inv_l, o[1] * inv_l); w.y = pk16(o[2] * inv_l, o[3] * inv_l);
            *(u32x2*)(orow + 64 * dc + 16 * dt) = w; }
        if (dc < 7) AT_WRITE((dc + 1) & 1);
        __syncthreads();
    }
#undef AT_LOAD
#undef AT_WRITE
}

__global__ void __launch_bounds__(512, 2) mk_fwd(Args a) {
    extern __shared__ __attribute__((aligned(16))) unsigned char lds_raw[];
    LAS unsigned char* lds = (LAS unsigned char*)lds_raw;
    volatile LAS unsigned* MISC = (volatile LAS unsigned*)(lds + MISC_OFF);
    const int G = gridDim.x, bx = blockIdx.x;
#define OPAQUE_TID() int tid = threadIdx.x; asm volatile("" : "+v"(tid)); const int lane = tid & 63, wave = __builtin_amdgcn_readfirstlane(tid >> 6); (void)lane; (void)wave
    const int vcu = (G % 8 == 0) ? (bx % 8) * (G / 8) + bx / 8 : bx;
    unsigned char* ws = a.ws;
    if (threadIdx.x < 64) MISC[threadIdx.x] = 0u;
    __syncthreads();
    XcdBarrier bar; bar.bar = (unsigned*)(ws + WS_CTL) + CW_BAR; bar.x = 0; bar.st = nullptr;
    if (!MK_PER_STEP) bar = xcd_barrier_post((unsigned*)(ws + WS_CTL) + CW_BAR, MISC + 8);

    f16_t* XA = (f16_t*)(ws + WS_XA); f16_t* XB = (f16_t*)(ws + WS_XB); f16_t* ACT = (f16_t*)(ws + WS_ACT);
    f16_t* XC = ACT;
    float* P1 = (float*)(ws + WS_PART1); float* P2 = (float*)(ws + WS_PART2); float* P3 = (float*)(ws + WS_PART3);

    for (int st = a.lo; st < a.hi; ++st) {
      const int nrep = ((MK_REP_MASK >> st) & 1) ? 2 : 1;
      for (int rep = 0; rep < nrep; ++rep) {
        if (st == ST_PREP) { OPAQUE_TID(); step_prep(a, lds, G, vcu, tid, wave, lane); }
        else if (st == ST_G1 || st == ST_G7) {
            pg8::Gemm g{st == ST_G1 ? XA : XB, (const f16_t*)(ws + (st == ST_G1 ? WS_W1IN : WS_W2IN)), TROWS, 2 * DFF, DM}; pg8::StaticOrder S; S.init(TROWS, 2 * DFF, G, bx);
            pg8::EpiSwiGLU E{ACT, st == ST_G1 ? nullptr : P3};
            pg8::gemm_phase(lds, g, S, E);
            { const int nbusy = S.nwg % G;
              if (bx >= nbusy) { OPAQUE_TID(); conv_set(a, lds, st == ST_G1 ? 1 : 3, (bx - nbusy) * 8 + wave, (G - nbusy) * 8, wave, lane); } }
        } else if (st == ST_G2 || st == ST_G4 || st == ST_G6 || st == ST_G8) {
            const f16_t* A; const f16_t* Bt; int K; const float* b32; float* part; float alpha;
            if (st == ST_G2)      { A = ACT; Bt = (const f16_t*)(ws + WS_W1OUT);   K = DFF; b32 = inp(I_X); part = P1;      alpha = 0.5f; }
            else if (st == ST_G4) { A = XA;  Bt = (const f16_t*)(ws + WS_WMIXOUT); K = DM;  b32 = nullptr;  part = P2;      alpha = 1.0f; }
            else if (st == ST_G6) { A = XC;  Bt = (const f16_t*)(ws + WS_WO);      K = DM;  b32 = nullptr;  part = P3;      alpha = 1.0f; }
            else                  { A = ACT; Bt = (const f16_t*)(ws + WS_W2OUT);   K = DFF; b32 = nullptr;  part = nullptr; alpha = 0.5f; }
            pg8::Gemm g{A, Bt, TROWS, DM, K}; pg8::StaticOrder S; S.init(TROWS, DM, G, bx);
            pg8::EpiRes E{b32, XB, (rep + 1 < nrep) ? (f16_t*)(ws + WS_END) : XB, part, alpha};
            pg8::gemm_phase(lds, g, S, E);
        } else if (st == ST_G3 || st == ST_G5 || st == ST_KV) {
            const f16_t* A; const f16_t* Bt; int M, N, ldc, c; f16_t* O; const float* part; float scale;
            if (st == ST_G3)      { A = XB; Bt = (const f16_t*)(ws + WS_WMIXIN); M = TROWS; N = INC;    O = ACT; ldc = INC;    part = P1; scale = 1.0f; c = bx; }
            else if (st == ST_G5) { A = XB; Bt = (const f16_t*)(ws + WS_WQ);     M = TROWS; N = DM;     O = XA;  ldc = DM;     part = P2; scale = 0.04419417382f * 1.44269504089f; c = bx; }
            else                  { A = (const f16_t*)(ws + WS_MEMN); Bt = (const f16_t*)(ws + WS_WKV); M = MROWS; N = 2 * DM; O = (f16_t*)(ws + WS_KV); ldc = 2 * DM; part = nullptr; scale = 1.0f; c = (bx + G / 2) % G; }
            pg8::Gemm g{A, Bt, M, N, DM}; pg8::StaticOrder S; S.init(M, N, G, c);
            pg8::EpiF16 E{O, ldc, part, scale};
            pg8::gemm_phase(lds, g, S, E);
            if (st == ST_KV) { int first = G / 2 + (MROWS / 256) * (2 * DM / 256); if (first >= G) first = 0;
                if (bx >= first) { OPAQUE_TID(); conv_set(a, lds, 2, (bx - first) * 8 + wave, (G - first) * 8, wave, lane); } }
        } else if (st == ST_MIX) {
            OPAQUE_TID();
            for (int u = vcu; u < TROWS / 32; u += G) conv_unit(a, u, tid);
            for (int u = vcu; u < (TROWS / 128) * 8; u += G) gm_unit(a, lds, u, tid, wave, lane);
        } else if (st == ST_ATT) {
            OPAQUE_TID();
            for (int u = bx; u < NB * XH * (SEQ / 128); u += G) { const int pair = u & 7, qb = u >> 3; attn_unit(a, lds, pair >> 2, pair & 3, qb, tid, wave, lane); }
        } else if (st == ST_FIN) {
            OPAQUE_TID();
            const int gw = vcu * 8 + wave, NGW = G * 8;
            for (int m = gw; m < TROWS; m += NGW) {
                const u32x4* xr = (const u32x4*)(XB + (size_t)m * DM) + lane; const GAS f32x4* gr = (const GAS f32x4*)inp(I_GFINAL); f32x4* orow = (f32x4*)(a.out + (size_t)m * DM);
                float v[4][8]; float s = 0.f;
#pragma unroll
                for (int j = 0; j < 4; ++j) { f16x8_to_f32(xr[64 * j], v[j]);
#pragma unroll
                    for (int e = 0; e < 8; ++e) s += v[j][e] * v[j][e]; }
                const float rs = __builtin_amdgcn_rsqf(wave_sum(s) * (1.f / DM) + EPS);
#pragma unroll
                for (int j = 0; j < 4; ++j) { const int c4 = 2 * (lane + 64 * j); const f32x4 g0 = gr[c4], g1 = gr[c4 + 1];
                    orow[c4] = (f32x4){v[j][0] * rs * g0[0], v[j][1] * rs * g0[1], v[j][2] * rs * g0[2], v[j][3] * rs * g0[3]};
                    orow[c4 + 1] = (f32x4){v[j][4] * rs * g1[0], v[j][5] * rs * g1[1], v[j][6] * rs * g1[2], v[j][7] * rs * g1[3]}; }
            }
        }
        if (!MK_PER_STEP && rep + 1 < nrep) xcd_barrier(bar);
      }
        if (MK_PROBE_AT == st) {
            xcd_barrier(bar);
            pg8::Gemm g{MK_PROBE_KIND == 0 ? ACT : XA, (const f16_t*)(ws + (MK_PROBE_KIND == 0 ? WS_W1OUT : WS_WMIXOUT)), TROWS, DM, MK_PROBE_KIND == 0 ? DFF : DM, MK_PROBE_MA, MK_PROBE_MB};
            pg8::StaticOrder S; S.init(TROWS, DM, G, bx);
            pg8::EpiF16 E{(f16_t*)(ws + WS_END), DM, nullptr, 1.0f};
            pg8::gemm_phase(lds, g, S, E);
        }
        if (!MK_PER_STEP && st + 1 < a.hi && st != ST_G3) { for (int br = 0; br < MK_BAR_REP; ++br) xcd_barrier(bar); }
    }
}


#ifndef MK_DEBUG
#define MK_DEBUG 0
#endif
#if MK_DEBUG
constexpr size_t WS_HOLD = 388 * MiB;
__device__ __forceinline__ unsigned hash32(unsigned x) { x ^= x >> 16; x *= 0x7feb352du; x ^= x >> 15; x *= 0x846ca68bu; x ^= x >> 16; return x; }
__device__ __forceinline__ float r16(float v) { return (float)(_Float16)v; }
__device__ __forceinline__ bool bad(float got, float ref) { return !(fabsf(got - ref) <= 0.02f * fabsf(ref) + 0.02f); }
__device__ __forceinline__ float rs_of_row(const f16_t* H, int r) { float s = 0.f; for (int c = 0; c < DM; ++c) { const float v = (float)H[(size_t)r * DM + c]; s += v * v; } return 1.0f / sqrtf(s / DM + EPS); }
__global__ void chk_step(Args a, int st, unsigned* flags) {
    const unsigned char* ws = a.ws; const unsigned sid = blockIdx.x * blockDim.x + threadIdx.x; const unsigned h1 = hash32(sid * 2654435761u + 12345u + st * 977u), h2 = hash32(h1 + 0x9e3779b9u);
    const f16_t* HOLD = (const f16_t*)(ws + WS_HOLD);
    const f16_t* XA = (const f16_t*)(ws + WS_XA); const f16_t* XB = (const f16_t*)(ws + WS_XB); const f16_t* ACT = (const f16_t*)(ws + WS_ACT);
    bool f = false;
    if (st == ST_PREP || (st == ST_FIN && (sid & 1))) {
        int which = sid % 13; if (st == ST_PREP) { if (which >= 2 && which < 10) which = which & 1; } else which = 2 + (sid >> 1) % 8;
        if (which < 10) {
            int ii, K, N, gi = -1; size_t off;
            switch (which) { case 0: ii = I_W1IN; K = DM; N = 2 * DFF; off = WS_W1IN; break; case 1: ii = I_W1OUT; K = DFF; N = DM; off = WS_W1OUT; break; case 2: ii = I_WMIXIN; K = DM; N = INC; off = WS_WMIXIN; gi = I_GMIX; break;
                case 3: ii = I_WMIXOUT; K = DM; N = DM; off = WS_WMIXOUT; break; case 4: ii = I_WQ; K = DM; N = DM; off = WS_WQ; gi = I_GXATTN; break; case 5: ii = I_WK; K = DM; N = DM; off = WS_WKV; break;
                case 6: ii = I_WV; K = DM; N = DM; off = WS_WKV; break; case 7: ii = I_WO; K = DM; N = DM; off = WS_WO; break; case 8: ii = I_W2IN; K = DM; N = 2 * DFF; off = WS_W2IN; gi = I_GFFN2; break; default: ii = I_W2OUT; K = DFF; N = DM; off = WS_W2OUT; break; }
            const float* Wsrc = a.in[0]; const float* gsrc = nullptr; for (int q = 0; q < 23; ++q) { if (q == ii) Wsrc = a.in[q]; if (q == gi) gsrc = a.in[q]; }
            const int k = h1 % K, n = h2 % N; int row = n;
            if (which == 0 || which == 8) { const int up = n >= DFF, nn = n - up * DFF; row = (nn >> 7) * 256 + up * 128 + (nn & 127); }
            if (which == 6) row = n + DM;
            const float ref = r16(Wsrc[(size_t)k * N + n] * (gsrc ? gsrc[k] : 1.f)), got = (float)((const f16_t*)(ws + off))[(size_t)row * K + k];
            f = !(fabsf(got - ref) <= 1e-6f + 1e-3f * fabsf(ref));
        } else if (which == 10) { const int r = h1 % TROWS, c = h2 % DM; float s = 0.f; for (int j = 0; j < DM; ++j) { const float v = a.in[I_X][(size_t)r * DM + j]; s += v * v; }
            f = bad((float)XA[(size_t)r * DM + c], a.in[I_X][(size_t)r * DM + c] / sqrtf(s / DM + EPS) * a.in[I_GFFN1][c]);
        } else if (which == 11) { const int r = h1 % MROWS, c = h2 % DM; float s = 0.f; for (int j = 0; j < DM; ++j) { const float v = a.in[I_MEM][(size_t)r * DM + j]; s += v * v; }
            f = bad((float)((const f16_t*)(ws + WS_MEMN))[(size_t)r * DM + c], a.in[I_MEM][(size_t)r * DM + c] / sqrtf(s / DM + EPS) * a.in[I_GMEM][c]);
        } else { const int i = h1 % (8 * 128 * 128), t = (i >> 7) & 127, s = i & 127; f = bad((float)((const f16_t*)(ws + WS_WSP))[i], s <= t ? a.in[I_WSP][i] : 0.f); }
    } else if (st == ST_G1 || st == ST_G7) {
        const int r = h1 % TROWS, j = h2 % DFF; const float* W = a.in[st == ST_G1 ? I_W1IN : I_W2IN]; const f16_t* A = st == ST_G1 ? XA : XB; float g = 0.f, u = 0.f;
        for (int k = 0; k < DM; ++k) { const float x = (float)A[(size_t)r * DM + k], gg = st == ST_G7 ? a.in[I_GFFN2][k] : 1.f; g += x * r16(gg * W[(size_t)k * (2 * DFF) + j]); u += x * r16(gg * W[(size_t)k * (2 * DFF) + DFF + j]); }
        if (st == ST_G7) { const float rs = rs_of_row(XB, r); g *= rs; u *= rs; }
        f = bad((float)ACT[(size_t)r * DFF + j], g / (1.f + expf(-g)) * u);
    } else if (st == ST_G2 || st == ST_G4 || st == ST_G6 || st == ST_G8) {
        const int r = h1 % TROWS, c = h2 % DM; const f16_t* A; int K; const float* W; float base; const float* part; float alpha;
        if (st == ST_G2)      { A = ACT; K = DFF; W = a.in[I_W1OUT];  base = a.in[I_X][(size_t)r * DM + c];   part = (const float*)(ws + WS_PART1); alpha = 0.5f; }
        else if (st == ST_G4) { A = XA;  K = DM;  W = a.in[I_WMIXOUT]; base = (float)HOLD[(size_t)r * DM + c]; part = (const float*)(ws + WS_PART2); alpha = 1.f; }
        else if (st == ST_G6) { A = ACT; K = DM;  W = a.in[I_WO];      base = (float)HOLD[(size_t)r * DM + c]; part = (const float*)(ws + WS_PART3); alpha = 1.f; }
        else                  { A = ACT; K = DFF; W = a.in[I_W2OUT];  base = (float)HOLD[(size_t)r * DM + c]; part = nullptr; alpha = 0.5f; }
        float s = 0.f; for (int k = 0; k < K; ++k) s += (float)A[(size_t)r * K + k] * r16(W[(size_t)k * DM + c]);
        f = bad((float)XB[(size_t)r * DM + c], base + alpha * s);
        if (part) { float ps = 0.f; for (int j = 0; j < NPART; ++j) ps += part[(size_t)r * NPART + j]; float hs = 0.f; for (int j = 0; j < DM; ++j) { const float v = (float)XB[(size_t)r * DM + j]; hs += v * v; } f = f || bad(ps, hs); }
    } else if (st == ST_G3 || st == ST_G5) {
        const int N = st == ST_G3 ? INC : DM; const int r = h1 % TROWS, n = h2 % N; const float* W = a.in[st == ST_G3 ? I_WMIXIN : I_WQ]; const float* gg = a.in[st == ST_G3 ? I_GMIX : I_GXATTN]; const f16_t* O = st == ST_G3 ? ACT : XA;
        float s = 0.f; for (int k = 0; k < DM; ++k) s += (float)XB[(size_t)r * DM + k] * r16(gg[k] * W[(size_t)k * N + n]);
        s *= rs_of_row(XB, r); if (st == ST_G5) s *= 0.04419417382f * 1.44269504089f;
        f = bad((float)O[(size_t)r * N + n], s);
    } else if (st == ST_KV) {
        const int r = h1 % MROWS, n = h2 % (2 * DM); const float* W = a.in[n < DM ? I_WK : I_WV]; const int nn = n % DM; const f16_t* MN = (const f16_t*)(ws + WS_MEMN);
        float s = 0.f; for (int k = 0; k < DM; ++k) s += (float)MN[(size_t)r * DM + k] * r16(W[(size_t)k * DM + nn]);
        f = bad((float)((const f16_t*)(ws + WS_KV))[(size_t)r * 2 * DM + n], s);
    } else if (st == ST_MIX) {
        const int r = h1 % TROWS, c = h2 % DM, t = r & (SEQ - 1); const f16_t* Z = ACT; float ref;
        if (c < CW) { float acc = a.in[I_CONVB][c];
            for (int k = 0; k < 3; ++k) { const int tt = t - 2 + k; if (tt >= 0) { const size_t rr = (size_t)(r - 2 + k) * INC; acc += a.in[I_CONVW][k * CW + c] * (float)Z[rr + CW + c] * (float)Z[rr + 2 * CW + c]; } }
            ref = (float)Z[(size_t)r * INC + c] * acc;
        } else { const int cc = c - CW, head = cc >> 7, R0 = r & ~127, tq = r & 127; float sg = a.in[I_BSP][head * 128 + tq];
            for (int s = 0; s <= tq; ++s) { float ss = 0.f; for (int j = 0; j < 128; ++j) { const float v = (float)Z[(size_t)(R0 + s) * INC + 4 * CW + head * 128 + j]; ss += v * v; }
                const float vn = (float)Z[(size_t)(R0 + s) * INC + 4 * CW + cc] / sqrtf(ss / 128.f + EPS) * a.in[I_GGMV][cc]; sg += a.in[I_WSP][(size_t)head * 128 * 128 + tq * 128 + s] * vn; }
            ref = (float)Z[(size_t)r * INC + 3 * CW + cc] * sg; }
        f = bad((float)XA[(size_t)r * DM + c], ref);
    } else if (st == ST_ATT) {
        const int r = h1 % TROWS, c = h2 % DM, hh = c / XHD, b = r / SEQ; const f16_t* KV = (const f16_t*)(ws + WS_KV);
        float mx = -1e30f;
        for (int m = 0; m < NMEM; ++m) { float s = 0.f; for (int d = 0; d < XHD; ++d) s += (float)XA[(size_t)r * DM + hh * XHD + d] * (float)KV[(size_t)(b * NMEM + m) * 2 * DM + hh * XHD + d]; mx = fmaxf(mx, s); }
        float l = 0.f, o = 0.f;
        for (int m = 0; m < NMEM; ++m) { float s = 0.f; for (int d = 0; d < XHD; ++d) s += (float)XA[(size_t)r * DM + hh * XHD + d] * (float)KV[(size_t)(b * NMEM + m) * 2 * DM + hh * XHD + d];
            const float p = exp2f(s - mx); l += p; o += p * (float)KV[(size_t)(b * NMEM + m) * 2 * DM + DM + c]; }
        f = bad((float)ACT[(size_t)r * DM + c], o / l);
    } else if (st == ST_FIN) {
        const int r = h1 % TROWS, c = h2 % DM; f = bad(a.out[(size_t)r * DM + c], (float)XB[(size_t)r * DM + c] * rs_of_row(XB, r) * a.in[I_GFINAL][c]);
    }
    if (f) atomicOr(flags, 1u << st);
}
__global__ void chk_final(float* out, const unsigned* flags) {
    const size_t i = (size_t)blockIdx.x * blockDim.x + threadIdx.x;
    if (i < (size_t)TROWS * DM) out[i] = 0.f;
    if (i == 0) { const unsigned fl = *flags; int code = 0; for (int s = ST_N - 1; s >= 0; --s) if ((fl >> s) & 1u) code = s + 1; out[0] = (10.f + code) * 100.f; }
}
#endif

extern "C" void kernel_launch(void* const* d_in, const int* in_sizes, int n_in, void* d_out, int out_size, void* d_ws, size_t ws_size, hipStream_t stream) {
    static int grid = 0;
    if (grid == 0) {
        if (n_in != 23 || in_sizes[0] != TROWS * DM || out_size != TROWS * DM || ws_size < WS_END + ((MK_DEBUG || MK_REP_MASK || MK_PROBE_AT >= 0) ? 64 * MiB : 0)) {
            fprintf(stderr, "kernel_launch: built for 23 inputs, x/out of %d floats, >= %zu bytes of workspace; got n_in %d, in0 %d, out %d, ws %zu; nothing launched\n", TROWS * DM, (size_t)WS_END, n_in, n_in > 0 ? in_sizes[0] : -1, out_size, ws_size); grid = -1; return; }
        int dev = 0, cus = 0, per_cu = 0;
        if (hipGetDevice(&dev) != hipSuccess || hipDeviceGetAttribute(&cus, hipDeviceAttributeMultiprocessorCount, dev) != hipSuccess) { fprintf(stderr, "kernel_launch: device query failed\n"); grid = -1; return; }
        if (hipFuncSetAttribute((const void*)mk_fwd, hipFuncAttributeMaxDynamicSharedMemorySize, LDS_BYTES) != hipSuccess) { fprintf(stderr, "kernel_launch: hipFuncSetAttribute failed\n"); grid = -1; return; }
        if (hipOccupancyMaxActiveBlocksPerMultiprocessor(&per_cu, (const void*)mk_fwd, 512, LDS_BYTES) != hipSuccess || per_cu < 1) { fprintf(stderr, "kernel_launch: occupancy query reports %d blocks per CU; nothing launched\n", per_cu); (void)hipGetLastError(); grid = -1; return; }
        grid = cus;
    }
    if (grid < 0) return;
    if (hipMemsetAsync((char*)d_ws + WS_CTL, 0, CTL_ZERO_BYTES, stream) != hipSuccess) { fprintf(stderr, "kernel_launch: memset failed\n"); return; }
    Args a{};
    for (int i = 0; i < 23; ++i) a.in[i] = (const float*)d_in[i];
    a.out = (float*)d_out; a.ws = (unsigned char*)d_ws;
#if MK_PER_STEP
    for (int s = 0; s < ST_N; ++s) { a.lo = s; a.hi = s + 1;
#if MK_DEBUG
        if (s == ST_G4 || s == ST_G6 || s == ST_G8) (void)hipMemcpyAsync((char*)d_ws + WS_HOLD, (char*)d_ws + WS_XB, (size_t)TROWS * DM * 2, hipMemcpyDeviceToDevice, stream);
#endif
        hipLaunchKernelGGL(mk_fwd, dim3(grid), dim3(512), LDS_BYTES, stream, a);
#if MK_DEBUG
        hipLaunchKernelGGL(chk_step, dim3(16), dim3(256), 0, stream, a, s, (unsigned*)d_ws + 64);
#endif
    }
#if MK_DEBUG
    hipLaunchKernelGGL(chk_final, dim3(TROWS * DM / 256), dim3(256), 0, stream, (float*)d_out, (const unsigned*)d_ws + 64);
#endif
#else
    a.lo = 0; a.hi = ST_N;
    hipLaunchKernelGGL(mk_fwd, dim3(grid), dim3(512), LDS_BYTES, stream, a);
#endif
    const hipError_t le = hipPeekAtLastError();
    if (le != hipSuccess) fprintf(stderr, "kernel_launch: launch failed: %s\n", hipGetErrorName(le));
}
```
